# Optimizing an MI355X kernel written in HIP

```python
import math
import jax, jax.numpy as jnp
from jax import lax
import numpy as np

D_MODEL = 1024
BATCH = 4
SEQ = 8192
DEPTH = 2

D_MIX = D_MODEL
D_LRU = 3 * D_MODEL // 8
D_RET = 3 * D_MODEL // 8
D_SSM = D_MIX - D_LRU - D_RET
LRU_HEADS = 6
LRU_BLOCK = D_LRU // LRU_HEADS
CONV_WIDTH = 4
LRU_C = 8.0
RET_HEADS = 6
RET_HEAD_DIM = D_RET // RET_HEADS
RET_CHUNK = 128
ROPE_BASE = 10000.0
SSM_GROUP = 16
SSM_GROUPS = D_SSM // SSM_GROUP
SSM_STATE = 64
D_FF = ((8 * D_MODEL // 3 + 255) // 256) * 256
N_IN = 2 * D_LRU + 4 * D_RET + D_SSM
SPLITS = (D_LRU, 2 * D_LRU, 2 * D_LRU + D_RET, 2 * D_LRU + 2 * D_RET,
          2 * D_LRU + 3 * D_RET, 2 * D_LRU + 4 * D_RET)
N_MOD = 9
DEEPNORM_ALPHA = (2.0 * DEPTH) ** 0.25
DEEPNORM_BETA = (8.0 * DEPTH) ** -0.25
MACARON_HALF = 0.5
LN_EPS = 1e-5

kernel_name = "hymba_style_lru_retention_s5_macaron_deepnorm"

F32 = jnp.float32


def layer_norm(x, g, b):
    xf = x.astype(F32)
    mu = jnp.mean(xf, -1, keepdims=True)
    var = jnp.mean(jnp.square(xf - mu), -1, keepdims=True)
    return ((xf - mu) * lax.rsqrt(var + LN_EPS) * g.astype(F32) + b.astype(F32)).astype(x.dtype)


def modulate(x, shift, scale):
    return x * (1.0 + scale[:, None, :]) + shift[:, None, :]


def swiglu(h, w1, w3, w2):
    return (jax.nn.silu(h @ w1) * (h @ w3)) @ w2


def causal_conv(u, w, b):
    S = u.shape[1]
    up = jnp.pad(u, ((0, 0), (CONV_WIDTH - 1, 0), (0, 0)))
    out = b
    for k in range(CONV_WIDTH):
        out = out + up[:, k:k + S, :] * w[k]
    return out


def _linear_combine(e1, e2):
    a1, b1 = e1
    a2, b2 = e2
    return a1 * a2, a2 * b1 + b2


def rglru(u, w_a, b_a, w_x, b_x, lam):
    Bsz, S, _ = u.shape
    uh = u.reshape(Bsz, S, LRU_HEADS, LRU_BLOCK)
    r = jax.nn.sigmoid(jnp.einsum('bshi,hij->bshj', uh, w_a).reshape(Bsz, S, D_LRU) + b_a).astype(F32)
    i = jax.nn.sigmoid(jnp.einsum('bshi,hij->bshj', uh, w_x).reshape(Bsz, S, D_LRU) + b_x).astype(F32)
    log_a = -LRU_C * r * jax.nn.softplus(-lam.astype(F32))
    a = jnp.exp(log_a)
    bterm = jnp.sqrt(-jnp.expm1(2.0 * log_a)) * (i * u.astype(F32))
    _, h = lax.associative_scan(_linear_combine, (a, bterm), axis=1)
    return h.astype(u.dtype)


def rotary(t, pos):
    half = RET_HEAD_DIM // 2
    inv = ROPE_BASE ** (-jnp.arange(half, dtype=F32) / half)
    ang = pos.astype(F32)[..., None] * inv
    cos = jnp.cos(ang)[:, :, None, :]
    sin = jnp.sin(ang)[:, :, None, :]
    tf = t.astype(F32)
    t1, t2 = tf[..., :half], tf[..., half:]
    return jnp.concatenate([t1 * cos - t2 * sin, t2 * cos + t1 * sin], -1)


def retention(q, k, v, g, pos, gn_g, gn_b):
    Bsz, S, _ = q.shape
    H, Dh, C = RET_HEADS, RET_HEAD_DIM, RET_CHUNK
    NC = S // C
    qr = rotary(q.reshape(Bsz, S, H, Dh), pos)
    kr = rotary(k.reshape(Bsz, S, H, Dh), pos) * (Dh ** -0.5)
    vr = v.astype(F32).reshape(Bsz, S, H, Dh)

    def chunks(t):
        return t.reshape(Bsz, NC, C, H, Dh).transpose(0, 3, 1, 2, 4)

    qc, kc, vc = chunks(qr), chunks(kr), chunks(vr)
    log_gamma = jnp.log1p(-jnp.exp2(-5.0 - jnp.arange(H, dtype=F32)))
    idx = jnp.arange(C, dtype=F32)
    diff = idx[:, None] - idx[None, :]
    causal = diff >= 0
    decay_mask = jnp.where(causal, jnp.exp(log_gamma[:, None, None] * jnp.where(causal, diff, 0.0)), 0.0)
    scores = jnp.einsum('bhnqd,bhnkd->bhnqk', qc, kc) * decay_mask[:, None]
    o_inner = jnp.einsum('bhnqk,bhnkd->bhnqd', scores, vc)
    k_decay = jnp.exp(log_gamma[:, None] * (C - 1 - idx))
    kv = jnp.einsum('bhnkd,bhnke->bhnde', kc * k_decay[:, None, :, None], vc)
    chunk_decay = jnp.exp(log_gamma * C)[None, :, None, None]

    def step(state, kv_n):
        return chunk_decay * state + kv_n, state

    init = jnp.zeros((Bsz, H, Dh, Dh), F32)
    _, prev = lax.scan(step, init, kv.transpose(2, 0, 1, 3, 4))
    prev = prev.transpose(1, 2, 0, 3, 4)
    q_decay = jnp.exp(log_gamma[:, None] * (idx + 1.0))
    o_cross = jnp.einsum('bhnqd,bhnde->bhnqe', qc * q_decay[:, None, :, None], prev)
    o = o_inner + o_cross
    mu = jnp.mean(o, -1, keepdims=True)
    var = jnp.mean(jnp.square(o - mu), -1, keepdims=True)
    o = (o - mu) * lax.rsqrt(var + LN_EPS)
    o = o.transpose(0, 2, 3, 1, 4).reshape(Bsz, S, D_RET) * gn_g.astype(F32) + gn_b.astype(F32)
    return (jax.nn.silu(g.astype(F32)) * o).astype(q.dtype)


def _complex_combine(e1, e2):
    ar1, ai1, br1, bi1 = e1
    ar2, ai2, br2, bi2 = e2
    return (ar2 * ar1 - ai2 * ai1, ar2 * ai1 + ai2 * ar1,
            ar2 * br1 - ai2 * bi1 + br2, ar2 * bi1 + ai2 * br1 + bi2)


def s5(u, lam_re, lam_im, log_step, b_re, b_im, c_re, c_im, d_skip, w_glu, b_glu):
    Bsz, S, _ = u.shape
    uf = u.astype(F32).reshape(Bsz, S, SSM_GROUPS, SSM_GROUP)
    lr, li = lam_re.astype(F32), lam_im.astype(F32)
    dt = jnp.exp(log_step.astype(F32))[:, None]
    mag = jnp.exp(lr * dt)
    zr, zi = mag * jnp.cos(li * dt), mag * jnp.sin(li * dt)
    den = lr * lr + li * li
    er = ((zr - 1.0) * lr + zi * li) / den
    ei = (zi * lr - (zr - 1.0) * li) / den
    br, bi = b_re.astype(F32), b_im.astype(F32)
    bbar_re = er[..., None] * br - ei[..., None] * bi
    bbar_im = er[..., None] * bi + ei[..., None] * br
    bu_re = jnp.einsum('bsgh,gph->bsgp', uf, bbar_re)
    bu_im = jnp.einsum('bsgh,gph->bsgp', uf, bbar_im)
    a_re = jnp.broadcast_to(zr, (1, S, SSM_GROUPS, SSM_STATE))
    a_im = jnp.broadcast_to(zi, (1, S, SSM_GROUPS, SSM_STATE))
    _, _, xr, xi = lax.associative_scan(_complex_combine, (a_re, a_im, bu_re, bu_im), axis=1)
    y = (jnp.einsum('bsgp,ghp->bsgh', xr, c_re.astype(F32))
         - jnp.einsum('bsgp,ghp->bsgh', xi, c_im.astype(F32)))
    y = y.reshape(Bsz, S, D_SSM) + d_skip.astype(F32) * u.astype(F32)
    y = jax.nn.gelu(y)
    y = y * jax.nn.sigmoid(y @ w_glu.astype(F32) + b_glu.astype(F32))
    return y.astype(u.dtype)


def token_mixer(h, pos, w_in, conv_w, conv_b, lru_wa, lru_ba, lru_wx, lru_bx, lru_lam,
                ret_gn_g, ret_gn_b, ssm_lam_re, ssm_lam_im, ssm_log_step, ssm_b_re, ssm_b_im,
                ssm_c_re, ssm_c_im, ssm_d, ssm_w_glu, ssm_b_glu, w_out):
    z = h @ w_in
    u_lru, g_lru, q, k, v, g_ret, u_ssm = jnp.split(z, SPLITS, axis=-1)
    y_lru = rglru(causal_conv(u_lru, conv_w, conv_b), lru_wa, lru_ba, lru_wx, lru_bx, lru_lam) * jax.nn.gelu(g_lru)
    y_ret = retention(q, k, v, g_ret, pos, ret_gn_g, ret_gn_b)
    y_ssm = s5(u_ssm, ssm_lam_re, ssm_lam_im, ssm_log_step, ssm_b_re, ssm_b_im,
               ssm_c_re, ssm_c_im, ssm_d, ssm_w_glu, ssm_b_glu)
    return jnp.concatenate([y_lru, y_ret, y_ssm], axis=-1) @ w_out


def _normal(k, shape, scale):
    return jax.random.normal(k, shape, F32) * scale


def setup_inputs(seed: int = 0) -> dict:
    key = jax.random.key(seed)
    ks = iter(jax.random.split(key, 48))
    L, D, F = DEPTH, D_MODEL, D_FF
    G, P, Hs = SSM_GROUPS, SSM_STATE, SSM_GROUP
    x = _normal(next(ks), (BATCH, SEQ, D), 1.0)
    c = _normal(next(ks), (BATCH, D), 1.0)
    positions = jnp.broadcast_to(jnp.arange(SEQ, dtype=jnp.int32)[None, :], (BATCH, SEQ))
    u_lam = jax.random.uniform(next(ks), (L, D_LRU), F32, 0.9, 0.999)
    a0 = u_lam ** (1.0 / LRU_C)
    lru_lam = jnp.log(a0) - jnp.log1p(-a0)
    return {
        "x": x, "c": c, "positions": positions,
        "ada_w": _normal(next(ks), (L, D, N_MOD * D), 0.5 * D ** -0.5),
        "ada_b": _normal(next(ks), (L, N_MOD * D), 0.01),
        "ln_g": 1.0 + _normal(next(ks), (L, 3, D), 0.02),
        "ln_b": _normal(next(ks), (L, 3, D), 0.01),
        "ffn1_w1": _normal(next(ks), (L, D, F), D ** -0.5),
        "ffn1_w3": _normal(next(ks), (L, D, F), D ** -0.5),
        "ffn1_w2": _normal(next(ks), (L, F, D), DEEPNORM_BETA * F ** -0.5),
        "mix_w_in": _normal(next(ks), (L, D, N_IN), D ** -0.5),
        "conv_w": _normal(next(ks), (L, CONV_WIDTH, D_LRU), CONV_WIDTH ** -0.5),
        "conv_b": _normal(next(ks), (L, D_LRU), 0.01),
        "lru_wa": _normal(next(ks), (L, LRU_HEADS, LRU_BLOCK, LRU_BLOCK), LRU_BLOCK ** -0.5),
        "lru_ba": _normal(next(ks), (L, D_LRU), 0.01),
        "lru_wx": _normal(next(ks), (L, LRU_HEADS, LRU_BLOCK, LRU_BLOCK), LRU_BLOCK ** -0.5),
        "lru_bx": _normal(next(ks), (L, D_LRU), 0.01),
        "lru_lam": lru_lam,
        "ret_gn_g": 1.0 + _normal(next(ks), (L, D_RET), 0.02),
        "ret_gn_b": _normal(next(ks), (L, D_RET), 0.01),
        "ssm_lam_re": -0.5 + _normal(next(ks), (L, G, P), 0.005),
        "ssm_lam_im": math.pi * jnp.broadcast_to(jnp.arange(P, dtype=F32), (L, G, P)) + _normal(next(ks), (L, G, P), 0.005),
        "ssm_log_step": jax.random.uniform(next(ks), (L, G), F32, math.log(0.001), math.log(0.1)),
        "ssm_b_re": _normal(next(ks), (L, G, P, Hs), (2.0 * Hs) ** -0.5),
        "ssm_b_im": _normal(next(ks), (L, G, P, Hs), (2.0 * Hs) ** -0.5),
        "ssm_c_re": _normal(next(ks), (L, G, Hs, P), (2.0 * P) ** -0.5),
        "ssm_c_im": _normal(next(ks), (L, G, Hs, P), (2.0 * P) ** -0.5),
        "ssm_d": _normal(next(ks), (L, D_SSM), 1.0),
        "ssm_w_glu": _normal(next(ks), (L, D_SSM, D_SSM), D_SSM ** -0.5),
        "ssm_b_glu": _normal(next(ks), (L, D_SSM), 0.01),
        "mix_w_out": _normal(next(ks), (L, D_MIX, D), DEEPNORM_BETA * D_MIX ** -0.5),
        "ffn2_w1": _normal(next(ks), (L, D, F), D ** -0.5),
        "ffn2_w3": _normal(next(ks), (L, D, F), D ** -0.5),
        "ffn2_w2": _normal(next(ks), (L, F, D), DEEPNORM_BETA * F ** -0.5),
    }


def reference(x, c, positions, ada_w, ada_b, ln_g, ln_b, ffn1_w1, ffn1_w3, ffn1_w2,
              mix_w_in, conv_w, conv_b, lru_wa, lru_ba, lru_wx, lru_bx, lru_lam,
              ret_gn_g, ret_gn_b, ssm_lam_re, ssm_lam_im, ssm_log_step, ssm_b_re, ssm_b_im,
              ssm_c_re, ssm_c_im, ssm_d, ssm_w_glu, ssm_b_glu, mix_w_out,
              ffn2_w1, ffn2_w3, ffn2_w2):
    cond = jax.nn.silu(c)
    for l in range(DEPTH):
        mod = cond @ ada_w[l] + ada_b[l]
        sh1, sc1, gt1, sh2, sc2, gt2, sh3, sc3, gt3 = jnp.split(mod, N_MOD, axis=-1)
        f1 = swiglu(modulate(x, sh1, sc1), ffn1_w1[l], ffn1_w3[l], ffn1_w2[l])
        x = layer_norm(DEEPNORM_ALPHA * x + MACARON_HALF * gt1[:, None, :] * f1, ln_g[l, 0], ln_b[l, 0])
        m = token_mixer(modulate(x, sh2, sc2), positions, mix_w_in[l], conv_w[l], conv_b[l],
                        lru_wa[l], lru_ba[l], lru_wx[l], lru_bx[l], lru_lam[l],
                        ret_gn_g[l], ret_gn_b[l], ssm_lam_re[l], ssm_lam_im[l], ssm_log_step[l],
                        ssm_b_re[l], ssm_b_im[l], ssm_c_re[l], ssm_c_im[l], ssm_d[l],
                        ssm_w_glu[l], ssm_b_glu[l], mix_w_out[l])
        x = layer_norm(DEEPNORM_ALPHA * x + gt2[:, None, :] * m, ln_g[l, 1], ln_b[l, 1])
        f2 = swiglu(modulate(x, sh3, sc3), ffn2_w1[l], ffn2_w3[l], ffn2_w2[l])
        x = layer_norm(DEEPNORM_ALPHA * x + MACARON_HALF * gt3[:, None, :] * f2, ln_g[l, 2], ln_b[l, 2])
    return x
```

```cpp
#include <hip/hip_runtime.h>
#include <hip/hip_cooperative_groups.h>
#include <cstdio>
#include <cstdint>
namespace cg = cooperative_groups;

#define LAS __attribute__((address_space(3)))
typedef unsigned short bf16;
typedef unsigned u32x4_t __attribute__((ext_vector_type(4)));
typedef unsigned u32x2_t __attribute__((ext_vector_type(2)));
typedef float f4_t __attribute__((ext_vector_type(4)));
typedef short s16x8_t __attribute__((ext_vector_type(8)));
typedef short s16x4_t __attribute__((ext_vector_type(4)));

constexpr int DM = 1024, NB_ = 4, SEQ = 8192, MTOK = NB_ * SEQ, NLAYER = 2, DFF = 2816, NIN = 2560;
constexpr int DLRU = 384, DRET = 384, DSSM = 256, NCH = 64, CHUNK = 128;
constexpr int ZC_ULRU = 0, ZC_GLRU = 384, ZC_Q = 768, ZC_K = 1152, ZC_V = 1536, ZC_GRET = 1920, ZC_USSM = 2304;
constexpr float ALPHA = 1.41421356237f, LNEPS = 1e-5f;

constexpr size_t MiB = 1u << 20;
constexpr size_t WS_MOD = 0, MOD_BYTES = (size_t)NLAYER * NB_ * 9 * DM * 4;
constexpr size_t WS_TAB = 1 * MiB;
constexpr size_t WS_SMALL = 9 * MiB;
constexpr size_t SM_WG = 0, SM_BCAT = 196608, SM_CCAT = 327680, SM_LZ = 458752, SM_WGLU = 524288;
constexpr size_t WS_W = 10 * MiB, W_LAYER = 40 * MiB;
constexpr size_t WO_13A = 0, WO_2A = 11 * MiB, WO_IN = 11 * MiB + 5632 * 1024, WO_OUT = WO_IN + 5 * MiB, WO_13B = WO_OUT + 2 * MiB, WO_2B = WO_13B + 11 * MiB;
constexpr size_t WS_CARRY = 90 * MiB, CA_LA = 0, CA_LH = 512 * 1024, CA_SR = 1 * MiB, CA_SI = 2 * MiB;
constexpr size_t WS_KV = 94 * MiB, WS_YS = 118 * MiB, WS_X = 134 * MiB, WS_H = 262 * MiB, WS_G = 326 * MiB, WS_END = 502 * MiB;
static_assert(WO_2B + 5632 * 1024 == W_LAYER, "weight map");

constexpr int LDS_BYTES = 131072 + 1024;

struct Params {
    const float* x; const float* c; const int* pos;
    const float* ada_w; const float* ada_b; const float* ln_g; const float* ln_b;
    const float* f1w1; const float* f1w3; const float* f1w2;
    const float* w_in; const float* conv_w; const float* conv_b;
    const float* lru_wa; const float* lru_ba; const float* lru_wx; const float* lru_bx; const float* lru_lam;
    const float* gn_g; const float* gn_b;
    const float* s_lre; const float* s_lim; const float* s_lstep; const float* s_bre; const float* s_bim; const float* s_cre; const float* s_cim; const float* s_d; const float* s_wglu; const float* s_bglu;
    const float* w_out; const float* f2w1; const float* f2w3; const float* f2w2;
    float* out; unsigned char* ws;
};

__device__ __forceinline__ unsigned f2bf(float f) { unsigned u = __builtin_bit_cast(unsigned, f); return (u + 0x7fffu + ((u >> 16) & 1u)) >> 16; }
__device__ __forceinline__ unsigned pk2(float lo, float hi) { return f2bf(lo) | (f2bf(hi) << 16); }
__device__ __forceinline__ float bflo(unsigned w) { return __uint_as_float(w << 16); }
__device__ __forceinline__ float bfhi(unsigned w) { return __uint_as_float(w & 0xffff0000u); }
__device__ __forceinline__ float bf1(bf16 h) { return __uint_as_float((unsigned)h << 16); }
__device__ __forceinline__ float fsigmoid(float x) { return __builtin_amdgcn_rcpf(1.f + __expf(-x)); }
__device__ __forceinline__ float fsilu(float x) { return x * fsigmoid(x); }
__device__ __forceinline__ float fgelu(float x) { return x * fsigmoid(1.5957691216f * (x + 0.044715f * x * x * x)); }
#define WAVE_SYNC() do { asm volatile("s_waitcnt lgkmcnt(0)" ::: "memory"); __builtin_amdgcn_wave_barrier(); asm volatile("" ::: "memory"); } while (0)

namespace pg8 {
#define PG8_LAS __attribute__((address_space(3)))
typedef unsigned short bf16_t;
typedef short bf16x8 __attribute__((ext_vector_type(8)));
typedef float f32x4 __attribute__((ext_vector_type(4)));
typedef unsigned u32x4 __attribute__((ext_vector_type(4)));
constexpr int BM = 256, BK = 64, HALF = 128, HTB = HALF * BK * 2  , STAGE_BYTES = 8 * HTB, NXCD = 8, WGM = 8;

__host__ __device__ __forceinline__ int lds_byte(int r, int c) { const int st = (r >> 4) * 2 + (c >> 5), rr = r & 15, cc = c & 31, ob = rr * 64 + cc * 2; return st * 1024 + (ob ^ (((ob >> 9) & 1) << 5)); }
__host__ __device__ __forceinline__ void stage_rc(int b, int& R, int& C) { const int st = b / 1024, sb = b % 1024, swz = sb ^ (((sb >> 9) & 1) << 5); R = (st >> 1) * 16 + swz / 64; C = (st & 1) * 32 + (swz % 64) / 2; }
__host__ __device__ __forceinline__ int perm32(int rho) { const int n = rho >> 4, i = rho & 15; return 8 * (i >> 2) + 4 * n + (i & 3); }

struct Unit { int pm, pn; };
struct Gemm { const bf16_t* A; const bf16_t* Bt; int M, N, K; };

struct StaticOrder {
    int nM, nN, nwg, G, c;
    __host__ __device__ void init(int M, int N, int G_, int c_) { nM = M / BM; nN = N / BM; nwg = nM * nN; G = G_; c = c_; }
    __host__ __device__ bool next(int i, Unit& u) const {
        const long L = (long)i * G + c; if (L >= nwg) return false;
        int wgid = (int)L; { const int q = nwg / NXCD, r = nwg % NXCD, xcd = wgid % NXCD, off = wgid / NXCD; wgid = (xcd < r ? xcd * (q + 1) : r * (q + 1) + (xcd - r) * q) + off; }
        const int nig = WGM * nN, gid = wgid / nig, fm = gid * WGM, gsz = (nM - fm) < WGM ? (nM - fm) : WGM;
        u.pm = fm + ((wgid % nig) % gsz); u.pn = (wgid % nig) / gsz; return true;
    }
    __device__ __forceinline__ void a_ready(const Unit&) const {}
    __device__ __forceinline__ void done(const Unit&) const {}
};

__device__ __forceinline__ unsigned cvt_pk_bf16(float lo, float hi) { unsigned r; asm volatile("v_cvt_pk_bf16_f32 %0, %1, %2" : "=v"(r) : "v"(lo), "v"(hi)); return r; }

struct EpiSwiglu {
    static constexpr bool PERM = true, AFTER_DRAIN = false;
    bf16_t* O; int ldo;
    __device__ __forceinline__ void operator()(const f32x4 (&acc)[2][2][4][2], const Unit& u, int wr, int wc, int fr, int fq) const {
        const int row0 = u.pm * BM + wr * 64 + fr, col0 = u.pn * HALF + wc * 32 + 8 * fq;
#pragma unroll
        for (int ai = 0; ai < 2; ++ai)
#pragma unroll
            for (int m = 0; m < 4; ++m) {
                bf16_t* rowp = O + (size_t)(row0 + ai * HALF + m * 16) * ldo + col0;
                const f32x4 g0 = acc[ai][0][m][0], g1 = acc[ai][0][m][1], u0 = acc[ai][1][m][0], u1 = acc[ai][1][m][1];
                u32x4 w;
                w.x = cvt_pk_bf16(fsilu(g0[0]) * u0[0], fsilu(g0[1]) * u0[1]); w.y = cvt_pk_bf16(fsilu(g0[2]) * u0[2], fsilu(g0[3]) * u0[3]);
                w.z = cvt_pk_bf16(fsilu(g1[0]) * u1[0], fsilu(g1[1]) * u1[1]); w.w = cvt_pk_bf16(fsilu(g1[2]) * u1[2], fsilu(g1[3]) * u1[3]);
                *(u32x4*)rowp = w;
            }
    }
};
struct EpiZ {
    static constexpr bool PERM = true, AFTER_DRAIN = false;
    bf16_t* O; const float* tab;
    __device__ __forceinline__ void operator()(const f32x4 (&acc)[2][2][4][2], const Unit& u, int wr, int wc, int fr, int fq) const {
        const int row0 = u.pm * BM + wr * 64 + fr, col0 = u.pn * BM + wc * 32 + 8 * fq;
        const bool rot = (u.pn >= 3 && u.pn <= 5);
#pragma unroll
        for (int ai = 0; ai < 2; ++ai)
#pragma unroll
            for (int m = 0; m < 4; ++m) {
                const int row = row0 + ai * HALF + m * 16;
#pragma unroll
                for (int bj = 0; bj < 2; ++bj) {
                    f32x4 v0 = acc[ai][bj][m][0], v1 = acc[ai][bj][m][1];
                    const int col = col0 + bj * HALF;
                    if (rot) {
                        const float* tp = tab + (size_t)row * 64 + (col & 63);
                        const f32x4 t0 = *(const f32x4*)tp, t1 = *(const f32x4*)(tp + 4);
                        f32x4 r0, r1;
                        r0[0] = v0[0] * t0[0] - v0[1] * t0[1]; r0[1] = v0[1] * t0[0] + v0[0] * t0[1];
                        r0[2] = v0[2] * t0[2] - v0[3] * t0[3]; r0[3] = v0[3] * t0[2] + v0[2] * t0[3];
                        r1[0] = v1[0] * t1[0] - v1[1] * t1[1]; r1[1] = v1[1] * t1[0] + v1[0] * t1[1];
                        r1[2] = v1[2] * t1[2] - v1[3] * t1[3]; r1[3] = v1[3] * t1[2] + v1[2] * t1[3];
                        v0 = r0; v1 = r1;
                    }
                    u32x4 w; w.x = cvt_pk_bf16(v0[0], v0[1]); w.y = cvt_pk_bf16(v0[2], v0[3]); w.z = cvt_pk_bf16(v1[0], v1[1]); w.w = cvt_pk_bf16(v1[2], v1[3]);
                    *(u32x4*)(O + (size_t)row * NIN + col) = w;
                }
            }
    }
};
struct EpiResid {
    static constexpr bool PERM = true, AFTER_DRAIN = false;
    const float* xin; float* out; const float* gate; float s;
    __device__ __forceinline__ void operator()(const f32x4 (&acc)[2][2][4][2], const Unit& u, int wr, int wc, int fr, int fq) const {
        const int row0 = u.pm * BM + wr * 64 + fr, col0 = u.pn * BM + wc * 32 + 8 * fq;
        const int b = (u.pm * BM) >> 13;
        f32x4 gv[2][2];
#pragma unroll
        for (int bj = 0; bj < 2; ++bj)
#pragma unroll
            for (int n = 0; n < 2; ++n) gv[bj][n] = *(const f32x4*)(gate + (size_t)b * 9216 + col0 + bj * HALF + 4 * n) * s;
#pragma unroll
        for (int ai = 0; ai < 2; ++ai)
#pragma unroll
            for (int m = 0; m < 4; ++m) {
                const size_t ro = (size_t)(row0 + ai * HALF + m * 16) * DM + col0;
#pragma unroll
                for (int bj = 0; bj < 2; ++bj)
#pragma unroll
                    for (int n = 0; n < 2; ++n) {
                        const f32x4 xi = *(const f32x4*)(xin + ro + bj * HALF + 4 * n);
                        *(f32x4*)(out + ro + bj * HALF + 4 * n) = xi * ALPHA + gv[bj][n] * acc[ai][bj][m][n];
                    }
            }
    }
};
struct EpiGlu {
    static constexpr bool PERM = true, AFTER_DRAIN = false;
    const bf16_t* YS; bf16_t* O; const float* bias;
    __device__ __forceinline__ void operator()(const f32x4 (&acc)[2][2][4][2], const Unit& u, int wr, int wc, int fr, int fq) const {
        const int row0 = u.pm * BM + wr * 64 + fr, col0 = wc * 32 + 8 * fq;
#pragma unroll
        for (int ai = 0; ai < 2; ++ai)
#pragma unroll
            for (int m = 0; m < 4; ++m) {
                const int row = row0 + ai * HALF + m * 16;
#pragma unroll
                for (int bj = 0; bj < 2; ++bj) {
                    const int col = col0 + bj * HALF;
                    const u32x4 yv = *(const u32x4*)(YS + (size_t)row * DSSM + col);
                    const f32x4 b0 = *(const f32x4*)(bias + col), b1 = *(const f32x4*)(bias + col + 4);
                    const f32x4 a0 = acc[ai][bj][m][0] + b0, a1 = acc[ai][bj][m][1] + b1;
                    u32x4 w;
                    w.x = cvt_pk_bf16(bflo(yv.x) * fsigmoid(a0[0]), bfhi(yv.x) * fsigmoid(a0[1])); w.y = cvt_pk_bf16(bflo(yv.y) * fsigmoid(a0[2]), bfhi(yv.y) * fsigmoid(a0[3]));
                    w.z = cvt_pk_bf16(bflo(yv.z) * fsigmoid(a1[0]), bfhi(yv.z) * fsigmoid(a1[1])); w.w = cvt_pk_bf16(bflo(yv.w) * fsigmoid(a1[2]), bfhi(yv.w) * fsigmoid(a1[3]));
                    *(u32x4*)(O + (size_t)row * DM + 768 + col) = w;
                }
            }
    }
};

template <class Epi, class Sched, bool ALIGN_EPI = false, bool SP2 = false>
__device__ __forceinline__ void gemm_phase(PG8_LAS unsigned char* lds, const Gemm g, const Sched& S, const Epi& E, const int tid) {
    const int wid = __builtin_amdgcn_readfirstlane(tid >> 6), lane = tid & 63, wr = wid >> 2, wc = wid & 3, fr = lane & 15, fq = lane >> 4;
    const int K = g.K, nt = K / BK;
    unsigned voffA[2], voffB[2];
#pragma unroll
    for (int i = 0; i < 2; ++i) { int R, C; stage_rc(tid * 16 + i * 8192, R, C); const int Rb = Epi::PERM ? ((R & ~31) + perm32(R & 31)) : R;
        voffA[i] = (unsigned)(R * K + C) * 2u; voffB[i] = (unsigned)(Rb * K + C) * 2u; }
    const size_t kstep = (size_t)(BK * 2);
    const size_t hstep = (size_t)HALF * K * 2;
    const size_t tstep = 2 * hstep;
    const unsigned ldsw = (unsigned)wid * 1024u;
    const int aoff = lds_byte(wr * 64 + fr, fq * 8), boff = lds_byte(wc * 32 + fr, fq * 8);
#define PG8_SA(b, h) (((b) * 2 + (h)) * HTB)
#define PG8_SB(b, h) ((4 + (b) * 2 + (h)) * HTB)
#define PG8_STAGE(bufoff, gbase, voff) do { _Pragma("unroll") for (int _i = 0; _i < 2; ++_i) \
        __builtin_amdgcn_global_load_lds((const unsigned*)((const char*)(gbase) + (voff)[_i]), (PG8_LAS unsigned*)(lds + (bufoff) + ldsw + _i * 8192), 16, 0, 0); } while (0)
#define PG8_LDA(dst, b, h) do { _Pragma("unroll") for (int m = 0; m < 4; ++m) _Pragma("unroll") for (int k = 0; k < 2; ++k) dst[m][k] = *(const PG8_LAS bf16x8*)(lds + PG8_SA(b, h) + aoff + m * 2048 + k * 1024); } while (0)
#define PG8_LDB(dst, b, h) do { _Pragma("unroll") for (int n = 0; n < 2; ++n) _Pragma("unroll") for (int k = 0; k < 2; ++k) dst[n][k] = *(const PG8_LAS bf16x8*)(lds + PG8_SB(b, h) + boff + n * 2048 + k * 1024); } while (0)
#define PG8_MMA(ai, bj, At, Bt) do { __builtin_amdgcn_s_setprio(1); _Pragma("unroll") for (int m = 0; m < 4; ++m) _Pragma("unroll") for (int n = 0; n < 2; ++n) _Pragma("unroll") for (int k = 0; k < 2; ++k) \
        acc[ai][bj][m][n] = __builtin_amdgcn_mfma_f32_16x16x32_bf16(Bt[n][k], At[m][k], acc[ai][bj][m][n], 0, 0, 0); __builtin_amdgcn_s_setprio(0); } while (0)
#define PG8_WAIT_V(n) asm volatile("s_waitcnt vmcnt(" #n ")" ::: "memory")
#define PG8_WAIT_L(n) asm volatile("s_waitcnt lgkmcnt(" #n ")" ::: "memory")
#define PG8_BAR __builtin_amdgcn_s_barrier()
#define PG8_SCHED __builtin_amdgcn_sched_barrier(0)
    Unit cur, nxt; int ui = 0;
    if (!S.next(0, cur)) return;
    f32x4 acc[2][2][4][2];
#pragma unroll
    for (int a = 0; a < 2; ++a)
#pragma unroll
        for (int b = 0; b < 2; ++b)
#pragma unroll
            for (int m = 0; m < 4; ++m)
#pragma unroll
                for (int n = 0; n < 2; ++n) acc[a][b][m][n] = (f32x4){0.f, 0.f, 0.f, 0.f};
    bf16x8 At[4][2], B0[2][2], B1[2][2];
    const char* cA = (const char*)g.A + (size_t)cur.pm * tstep; const char* cB = (const char*)g.Bt + (size_t)cur.pn * tstep;
    S.a_ready(cur);
    if constexpr (SP2) {
        PG8_STAGE(PG8_SB(0, 0), cB, voffB); PG8_STAGE(PG8_SB(0, 1), cB + hstep, voffB); PG8_STAGE(PG8_SA(0, 0), cA, voffA); PG8_STAGE(PG8_SA(0, 1), cA + hstep, voffA);
        if (wr == 1) PG8_BAR;
        PG8_WAIT_V(2); PG8_BAR;
        PG8_STAGE(PG8_SB(1, 0), cB + kstep, voffB); PG8_STAGE(PG8_SA(1, 0), cA + kstep, voffA); PG8_STAGE(PG8_SB(1, 1), cB + hstep + kstep, voffB);
        PG8_WAIT_V(6); PG8_BAR;
    } else {
        PG8_STAGE(PG8_SB(0, 0), cB, voffB); PG8_STAGE(PG8_SA(0, 0), cA, voffA); PG8_STAGE(PG8_SB(0, 1), cB + hstep, voffB); PG8_STAGE(PG8_SA(0, 1), cA + hstep, voffA);
        if (wr == 1) PG8_BAR;
        PG8_WAIT_V(4); PG8_BAR;
        PG8_STAGE(PG8_SB(1, 0), cB + kstep, voffB); PG8_STAGE(PG8_SA(1, 0), cA + kstep, voffA); PG8_STAGE(PG8_SB(1, 1), cB + hstep + kstep, voffB);
        PG8_WAIT_V(6); PG8_BAR;
    }
    for (;;) {
        const bool has_next = S.next(ui + 1, nxt);
        const char* nA = has_next ? (const char*)g.A + (size_t)nxt.pm * tstep : cA; const char* nB = has_next ? (const char*)g.Bt + (size_t)nxt.pn * tstep : cB;
        for (int t = 0; t < nt; t += 2) {
            const bool last = (t == nt - 2);
            const char* a1 = cA + (size_t)(t + 1) * kstep;
            const char* a2 = last ? nA : cA + (size_t)(t + 2) * kstep; const char* b2 = last ? nB : cB + (size_t)(t + 2) * kstep;
            const char* a3 = a2 + kstep; const char* b3 = b2 + kstep;
            if (last && has_next) S.a_ready(nxt);
            if constexpr (SP2) {
            PG8_LDB(B0, 0, 0); PG8_LDB(B1, 0, 1); PG8_SCHED; PG8_LDA(At, 0, 0); PG8_STAGE(PG8_SA(1, 1), a1 + hstep, voffA);
            PG8_WAIT_V(8); PG8_WAIT_L(0); PG8_BAR; PG8_MMA(0, 0, At, B0); PG8_MMA(0, 1, At, B1); PG8_BAR; PG8_SCHED;
            PG8_LDA(At, 0, 1); PG8_STAGE(PG8_SB(0, 0), b2, voffB); PG8_STAGE(PG8_SB(0, 1), b2 + hstep, voffB); PG8_STAGE(PG8_SA(0, 0), a2, voffA);
            PG8_WAIT_V(8); PG8_WAIT_L(0); PG8_BAR; PG8_MMA(1, 0, At, B0); PG8_MMA(1, 1, At, B1); PG8_BAR; PG8_SCHED;
            PG8_LDB(B0, 1, 0); PG8_LDB(B1, 1, 1); PG8_SCHED; PG8_LDA(At, 1, 0); PG8_STAGE(PG8_SA(0, 1), a2 + hstep, voffA);
            PG8_WAIT_V(8); PG8_WAIT_L(0); PG8_BAR; PG8_MMA(0, 0, At, B0); PG8_MMA(0, 1, At, B1); PG8_BAR; PG8_SCHED;
            PG8_LDA(At, 1, 1); PG8_STAGE(PG8_SB(1, 0), b3, voffB); PG8_STAGE(PG8_SB(1, 1), b3 + hstep, voffB); PG8_STAGE(PG8_SA(1, 0), a3, voffA);
            PG8_WAIT_V(8); PG8_WAIT_L(0); PG8_BAR; PG8_MMA(1, 0, At, B0); PG8_MMA(1, 1, At, B1); PG8_BAR; PG8_SCHED;
            } else {
            PG8_LDB(B0, 0, 0); PG8_SCHED; PG8_LDA(At, 0, 0); PG8_STAGE(PG8_SA(1, 1), a1 + hstep, voffA);
            PG8_WAIT_L(8); PG8_BAR; PG8_WAIT_L(0); PG8_MMA(0, 0, At, B0); PG8_BAR; PG8_SCHED;
            PG8_LDB(B1, 0, 1); PG8_STAGE(PG8_SB(0, 0), b2, voffB);
            PG8_BAR; PG8_WAIT_L(0); PG8_MMA(0, 1, At, B1); PG8_BAR;
            PG8_LDA(At, 0, 1); PG8_STAGE(PG8_SA(0, 0), a2, voffA);
            PG8_BAR; PG8_WAIT_L(0); PG8_MMA(1, 0, At, B0); PG8_BAR; PG8_SCHED;
            PG8_STAGE(PG8_SB(0, 1), b2 + hstep, voffB);
            PG8_WAIT_V(6); PG8_BAR; PG8_MMA(1, 1, At, B1); PG8_BAR;
            PG8_LDB(B0, 1, 0); PG8_SCHED; PG8_LDA(At, 1, 0); PG8_STAGE(PG8_SA(0, 1), a2 + hstep, voffA);
            PG8_WAIT_L(8); PG8_BAR; PG8_WAIT_L(0); PG8_MMA(0, 0, At, B0); PG8_BAR; PG8_SCHED;
            PG8_LDB(B1, 1, 1); PG8_STAGE(PG8_SB(1, 0), b3, voffB);
            PG8_BAR; PG8_WAIT_L(0); PG8_MMA(0, 1, At, B1); PG8_BAR;
            PG8_LDA(At, 1, 1); PG8_STAGE(PG8_SA(1, 0), a3, voffA);
            PG8_BAR; PG8_WAIT_L(0); PG8_MMA(1, 0, At, B0); PG8_BAR; PG8_SCHED;
            PG8_STAGE(PG8_SB(1, 1), b3 + hstep, voffB);
            PG8_WAIT_V(6); PG8_BAR; PG8_MMA(1, 1, At, B1); PG8_BAR;
            }
        }
        if constexpr (ALIGN_EPI) { if (wr == 0) PG8_BAR; }
        if constexpr (!Epi::AFTER_DRAIN) { E(acc, cur, wr, wc, fr, fq); S.done(cur); }
        if (!has_next) break;
#pragma unroll
        for (int a = 0; a < 2; ++a)
#pragma unroll
            for (int b = 0; b < 2; ++b)
#pragma unroll
                for (int m = 0; m < 4; ++m)
#pragma unroll
                    for (int n = 0; n < 2; ++n) acc[a][b][m][n] = (f32x4){0.f, 0.f, 0.f, 0.f};
        cur = nxt; cA = nA; cB = nB; ++ui;
        if constexpr (ALIGN_EPI) { if (wr == 1) PG8_BAR; }
    }
    PG8_WAIT_V(0);
    if constexpr (!ALIGN_EPI) { if (wr == 0) PG8_BAR; }
    PG8_BAR;
    if constexpr (Epi::AFTER_DRAIN) { E.fused(acc, cur, wr, wc, fr, fq, lds, wid, lane); S.done(cur); }
#undef PG8_SA
#undef PG8_SB
#undef PG8_STAGE
#undef PG8_LDA
#undef PG8_LDB
#undef PG8_MMA
#undef PG8_WAIT_V
#undef PG8_WAIT_L
#undef PG8_BAR
#undef PG8_SCHED
}
}

using pg8::f32x4;
typedef pg8::bf16x8 bf16x8;
#define MFMA16(a, b, c) __builtin_amdgcn_mfma_f32_16x16x32_bf16((a), (b), (c), 0, 0, 0)

__device__ __forceinline__ float wave_sum(float v) {
#pragma unroll
    for (int o = 1; o < 64; o <<= 1) v += __shfl_xor(v, o);
    return v;
}
__device__ __forceinline__ bf16x8 tr8(LAS const unsigned char* p0, LAS const unsigned char* p1) {
    const s16x4_t a = __builtin_amdgcn_ds_read_tr16_b64_v4i16((LAS s16x4_t*)p0);
    const s16x4_t b = __builtin_amdgcn_ds_read_tr16_b64_v4i16((LAS s16x4_t*)p1);
    return __builtin_shufflevector(a, b, 0, 1, 2, 3, 4, 5, 6, 7);
}
__device__ __forceinline__ bf16x8 pack8(f32x4 a, f32x4 b) {
    u32x4_t w; w.x = pk2(a[0], a[1]); w.y = pk2(a[2], a[3]); w.z = pk2(b[0], b[1]); w.w = pk2(b[2], b[3]);
    return __builtin_bit_cast(bf16x8, w);
}
__device__ __forceinline__ bf16x8 scale8(u32x4_t v, float s) {
    u32x4_t w; w.x = pk2(bflo(v.x) * s, bfhi(v.x) * s); w.y = pk2(bflo(v.y) * s, bfhi(v.y) * s); w.z = pk2(bflo(v.z) * s, bfhi(v.z) * s); w.w = pk2(bflo(v.w) * s, bfhi(v.w) * s);
    return __builtin_bit_cast(bf16x8, w);
}

__device__ __forceinline__ void tr_item(const float* W0, const float* W1, int K, int Nsrc, bf16* WT, int mode, LAS float* scr, int item, int nblk, int lane) {
    const int kb = item / nblk, nb = item % nblk, k0 = 64 * kb, n0 = 32 * nb;
    const int R = n0 + (lane & 31);
    const float* src = W0; int col = R; float sc = 1.f;
    if (mode == 1) { const int pn = R >> 8, bj = (R >> 7) & 1, cc = R & 127; src = bj ? W1 : W0; col = 128 * pn + cc; }
    else if (mode == 2) { if (R >= ZC_Q && R < ZC_V) { const int i = R & 63; col = (R & ~63) + (i >> 1) + 32 * (i & 1); if (R >= ZC_K) sc = 0.125f; } }
#pragma unroll 8
    for (int i = 0; i < 32; ++i) { const int kk = 2 * i + (lane >> 5); scr[kk * 33 + (lane & 31)] = src[(size_t)(k0 + kk) * Nsrc + col] * sc; }
    WAVE_SYNC();
    const int c = lane & 7;
#pragma unroll
    for (int j = 0; j < 4; ++j) { const int n = (lane >> 3) + 8 * j; const LAS float* s = scr + (8 * c) * 33 + n;
        u32x4_t o; o.x = pk2(s[0 * 33], s[1 * 33]); o.y = pk2(s[2 * 33], s[3 * 33]); o.z = pk2(s[4 * 33], s[5 * 33]); o.w = pk2(s[6 * 33], s[7 * 33]);
        *(u32x4_t*)(WT + (size_t)(n0 + n) * K + k0 + 8 * c) = o; }
    WAVE_SYNC();
}

__device__ __forceinline__ void prologue(const Params& p, LAS unsigned char* lds, int tid, int lane, int wave, int NBLK) {
    unsigned char* ws = p.ws;
    {
        LAS float* cond = (LAS float*)lds;
        for (int i = tid; i < NB_ * DM; i += 512) cond[i] = fsilu(p.c[i]);
        __syncthreads();
        float* mod = (float*)(ws + WS_MOD);
        for (int task = blockIdx.x; task < NLAYER * 18 * 16; task += NBLK) {
            const int l = task / 288, r = task % 288, jb = r / 16, ks = r % 16;
            const int j = jb * 512 + tid;
            const float* w = p.ada_w + (size_t)l * DM * 9216 + (size_t)(ks * 64) * 9216 + j;
            float a0 = 0.f, a1 = 0.f, a2 = 0.f, a3 = 0.f;
#pragma unroll 8
            for (int k = 0; k < 64; ++k) { const float wv = w[(size_t)k * 9216]; const int kk = ks * 64 + k;
                a0 += cond[kk] * wv; a1 += cond[DM + kk] * wv; a2 += cond[2 * DM + kk] * wv; a3 += cond[3 * DM + kk] * wv; }
            const float bb = (ks == 0) ? p.ada_b[l * 9216 + j] : 0.f;
            float* mo = mod + (size_t)l * NB_ * 9216 + j;
            atomicAdd(mo, a0 + bb); atomicAdd(mo + 9216, a1 + bb); atomicAdd(mo + 2 * 9216, a2 + bb); atomicAdd(mo + 3 * 9216, a3 + bb);
        }
        __syncthreads();
    }
    {
        LAS float* scr = (LAS float*)(lds + wave * 16384);
        const int gw = blockIdx.x * 8 + wave, NGW = NBLK * 8;
        constexpr int I13 = 16 * 176, I2 = 44 * 32, IIN = 16 * 80, IOUT = 16 * 32, IGLU = 4 * 8, IL = 2 * I13 + 2 * I2 + IIN + IOUT + IGLU;
        for (int it = gw; it < NLAYER * IL; it += NGW) {
            const int l = it / IL; int r = it % IL;
            unsigned char* wl = ws + WS_W + (size_t)l * W_LAYER;
            const size_t o13 = (size_t)l * DM * DFF, oin = (size_t)l * DM * NIN, oout = (size_t)l * DM * DM;
            if (r < I13) { tr_item(p.f1w1 + o13, p.f1w3 + o13, DM, DFF, (bf16*)(wl + WO_13A), 1, scr, r, 176, lane); continue; } r -= I13;
            if (r < I13) { tr_item(p.f2w1 + o13, p.f2w3 + o13, DM, DFF, (bf16*)(wl + WO_13B), 1, scr, r, 176, lane); continue; } r -= I13;
            if (r < I2) { tr_item(p.f1w2 + o13, nullptr, DFF, DM, (bf16*)(wl + WO_2A), 0, scr, r, 32, lane); continue; } r -= I2;
            if (r < I2) { tr_item(p.f2w2 + o13, nullptr, DFF, DM, (bf16*)(wl + WO_2B), 0, scr, r, 32, lane); continue; } r -= I2;
            if (r < IIN) { tr_item(p.w_in + oin, nullptr, DM, NIN, (bf16*)(wl + WO_IN), 2, scr, r, 80, lane); continue; } r -= IIN;
            if (r < IOUT) { tr_item(p.w_out + oout, nullptr, DM, DM, (bf16*)(wl + WO_OUT), 0, scr, r, 32, lane); continue; } r -= IOUT;
            tr_item(p.s_wglu + (size_t)l * DSSM * DSSM, nullptr, DSSM, DSSM, (bf16*)(ws + WS_SMALL + SM_WGLU) + (size_t)l * DSSM * DSSM, 0, scr, r, 8, lane);
        }
    }
    {
        const int gt = blockIdx.x * 512 + tid, NT = NBLK * 512;
        bf16* wg = (bf16*)(ws + WS_SMALL + SM_WG);
        for (int i = gt; i < NLAYER * 6 * 2 * 4096; i += NT) {
            const int ii = i & 63, jj = (i >> 6) & 63, gate = (i >> 12) & 1, lh = i >> 13;
            const float* src = gate ? p.lru_wx : p.lru_wa;
            wg[i] = (bf16)f2bf(src[(size_t)lh * 4096 + ii * 64 + jj]);
        }
        float* lz = (float*)(ws + WS_SMALL + SM_LZ); bf16* bc = (bf16*)(ws + WS_SMALL + SM_BCAT); bf16* cc = (bf16*)(ws + WS_SMALL + SM_CCAT);
        for (int i = gt; i < NLAYER * 16 * 64; i += NT) {
            const int pp = i & 63, lg = i >> 6;
            const float lr = p.s_lre[i], li = p.s_lim[i], dt = __expf(p.s_lstep[lg]);
            const float mag = __expf(lr * dt), zr = mag * cosf(li * dt), zi = mag * sinf(li * dt);
            const float den = lr * lr + li * li, er = ((zr - 1.f) * lr + zi * li) / den, ei = (zi * lr - (zr - 1.f) * li) / den;
            float pr = zr, pi = zi;
#pragma unroll
            for (int s = 0; s < 7; ++s) { const float nr = pr * pr - pi * pi, ni = 2.f * pr * pi; pr = nr; pi = ni; }
            lz[i * 4 + 0] = zr; lz[i * 4 + 1] = zi; lz[i * 4 + 2] = pr; lz[i * 4 + 3] = pi;
#pragma unroll
            for (int h = 0; h < 16; ++h) {
                const float br = p.s_bre[(size_t)i * 16 + h], bi = p.s_bim[(size_t)i * 16 + h];
                bc[((size_t)lg * 128 + pp) * 16 + h] = (bf16)f2bf(er * br - ei * bi);
                bc[((size_t)lg * 128 + 64 + pp) * 16 + h] = (bf16)f2bf(er * bi + ei * br);
            }
        }
        for (int i = gt; i < NLAYER * 16 * 16 * 64; i += NT) {
            const int pp = i & 63, lgh = i >> 6;
            cc[(size_t)lgh * 128 + pp] = (bf16)f2bf(p.s_cre[i]);
            cc[(size_t)lgh * 128 + 64 + pp] = (bf16)f2bf(-p.s_cim[i]);
        }
        float* tab = (float*)(ws + WS_TAB);
        for (int i = gt; i < MTOK * 32; i += NT) {
            const int f = i & 31, tok = i >> 5;
            const float inv = exp2f(-(float)f * (13.287712379549449f / 32.f));
            const float ang = (float)p.pos[tok] * inv;
            const double ad = (double)ang, nrev = __builtin_rint(ad * 0.15915494309189535);
            const float rr = (float)(ad - nrev * 6.283185307179586);
            tab[(size_t)i * 2] = cosf(rr); tab[(size_t)i * 2 + 1] = sinf(rr);
        }
    }
}

template <bool DO_LN>
__device__ __forceinline__ void ln_phase(const float* Y, float* Xout, bf16* Hout, const float* g, const float* bta, const float* sh, const float* sc, int gw, int NGW, int lane) {
    for (int m = gw; m < MTOK; m += NGW) {
        const f4_t* yr = (const f4_t*)(Y + (size_t)m * DM) + lane;
        f4_t v[4];
#pragma unroll
        for (int j = 0; j < 4; ++j) v[j] = yr[64 * j];
        if (DO_LN) {
            float s = 0.f;
#pragma unroll
            for (int j = 0; j < 4; ++j) s += (v[j].x + v[j].y) + (v[j].z + v[j].w);
            const float mean = wave_sum(s) * (1.f / DM); float s2 = 0.f;
#pragma unroll
            for (int j = 0; j < 4; ++j) { v[j] = v[j] - mean; s2 += (v[j].x * v[j].x + v[j].y * v[j].y) + (v[j].z * v[j].z + v[j].w * v[j].w); }
            const float rstd = 1.f / sqrtf(wave_sum(s2) * (1.f / DM) + LNEPS);
#pragma unroll
            for (int j = 0; j < 4; ++j) { const f4_t gg = ((const f4_t*)g)[lane + 64 * j], bb = ((const f4_t*)bta)[lane + 64 * j]; v[j] = v[j] * rstd * gg + bb; }
            if (Xout) {
                f4_t* xo = (f4_t*)(Xout + (size_t)m * DM) + lane;
#pragma unroll
                for (int j = 0; j < 4; ++j) xo[64 * j] = v[j];
            }
        }
        if (Hout) {
            const int b = m >> 13;
            const f4_t* shp = (const f4_t*)(sh + (size_t)b * 9216) + lane; const f4_t* scp = (const f4_t*)(sc + (size_t)b * 9216) + lane;
            u32x2_t* ho = (u32x2_t*)(Hout + (size_t)m * DM) + lane;
#pragma unroll
            for (int j = 0; j < 4; ++j) { const f4_t hv = v[j] * (scp[64 * j] + 1.f) + shp[64 * j]; u32x2_t o; o.x = pk2(hv.x, hv.y); o.y = pk2(hv.z, hv.w); ho[64 * j] = o; }
        }
    }
}

template <bool APPLY>
__device__ __forceinline__ void lru_task(const Params& p, int l, int task, LAS unsigned char* wl, int lane) {
    unsigned char* ws = p.ws;
    const int h = task % 6, bn = task / 6, n = bn & 63;
    const int tok0 = bn * CHUNK;
    const int c = h * 64 + lane, fr = lane & 15, fq = lane >> 4;
    const bf16* Z = (const bf16*)(ws + WS_G);
    bf16* Hb = (bf16*)(ws + WS_H);
    const float cw0 = p.conv_w[(l * 4 + 0) * DLRU + c], cw1 = p.conv_w[(l * 4 + 1) * DLRU + c], cw2 = p.conv_w[(l * 4 + 2) * DLRU + c], cw3 = p.conv_w[(l * 4 + 3) * DLRU + c];
    const float cb = p.conv_b[l * DLRU + c], ba = p.lru_ba[l * DLRU + c], bx = p.lru_bx[l * DLRU + c];
    const float sp8 = -8.f * log1pf(__expf(-p.lru_lam[l * DLRU + c]));
    bf16x8 Bw[2][4][2];
    {
        const bf16* wg = (const bf16*)(ws + WS_SMALL + SM_WG) + (size_t)(l * 6 + h) * 2 * 4096;
#pragma unroll
        for (int gt = 0; gt < 2; ++gt)
#pragma unroll
            for (int nt = 0; nt < 4; ++nt)
#pragma unroll
                for (int ks = 0; ks < 2; ++ks) Bw[gt][nt][ks] = *(const bf16x8*)(wg + gt * 4096 + (16 * nt + fr) * 64 + 32 * ks + 8 * fq);
    }
    float* LA = (float*)(ws + WS_CARRY + CA_LA); float* LH = (float*)(ws + WS_CARRY + CA_LH);
    float hst = APPLY ? LH[(size_t)bn * DLRU + c] : 0.f, ap = 1.f;
    float um3 = 0.f, um2 = 0.f, um1 = 0.f;
    if (n > 0) { um3 = bf1(Z[(size_t)(tok0 - 3) * NIN + ZC_ULRU + c]); um2 = bf1(Z[(size_t)(tok0 - 2) * NIN + ZC_ULRU + c]); um1 = bf1(Z[(size_t)(tok0 - 1) * NIN + ZC_ULRU + c]); }
    LAS bf16* Auc = (LAS bf16*)wl;
    LAS float* Rb = (LAS float*)(wl + 2304);
    LAS float* Ib = (LAS float*)(wl + 2304 + 4352);
#pragma unroll 1
    for (int st = 0; st < 8; ++st) {
        const int t0 = tok0 + 16 * st;
        float uc[16], gg[16];
        {
            float ur[16];
#pragma unroll
            for (int t = 0; t < 16; ++t) ur[t] = bf1(Z[(size_t)(t0 + t) * NIN + ZC_ULRU + c]);
            if (APPLY) {
#pragma unroll
                for (int t = 0; t < 16; ++t) gg[t] = bf1(Z[(size_t)(t0 + t) * NIN + ZC_GLRU + c]);
            }
#pragma unroll
            for (int t = 0; t < 16; ++t) {
                const float a3 = (t >= 3) ? ur[t - 3] : (t == 0 ? um3 : (t == 1 ? um2 : um1));
                const float a2 = (t >= 2) ? ur[t - 2] : (t == 0 ? um2 : um1);
                const float a1 = (t >= 1) ? ur[t - 1] : um1;
                uc[t] = cb + cw0 * a3 + cw1 * a2 + cw2 * a1 + cw3 * ur[t];
            }
            um3 = ur[13]; um2 = ur[14]; um1 = ur[15];
        }
#pragma unroll
        for (int t = 0; t < 16; ++t) Auc[t * 72 + lane] = (bf16)f2bf(uc[t]);
        WAVE_SYNC();
        {
            const bf16x8 A0 = *(const LAS bf16x8*)(Auc + fr * 72 + 8 * fq), A1 = *(const LAS bf16x8*)(Auc + fr * 72 + 32 + 8 * fq);
#pragma unroll
            for (int gt = 0; gt < 2; ++gt)
#pragma unroll
                for (int nt = 0; nt < 4; ++nt) {
                    f32x4 d = {0.f, 0.f, 0.f, 0.f};
                    d = MFMA16(A0, Bw[gt][nt][0], d); d = MFMA16(A1, Bw[gt][nt][1], d);
                    LAS float* dst = (gt ? Ib : Rb) + (4 * fq) * 68 + 16 * nt + fr;
                    dst[0] = d[0]; dst[68] = d[1]; dst[136] = d[2]; dst[204] = d[3];
                }
        }
        WAVE_SYNC();
#pragma unroll
        for (int t = 0; t < 16; ++t) {
            const float r = fsigmoid(Rb[t * 68 + lane] + ba), ig = fsigmoid(Ib[t * 68 + lane] + bx);
            const float la = sp8 * r, a = __expf(la);
            const float bt = sqrtf(fmaxf(-expm1f(2.f * la), 0.f)) * (ig * uc[t]);
            hst = a * hst + bt;
            if (APPLY) Hb[(size_t)(t0 + t) * DM + c] = (bf16)f2bf(hst * fgelu(gg[t]));
            else ap *= a;
        }
        WAVE_SYNC();
    }
    if (!APPLY) { LA[(size_t)bn * DLRU + c] = ap; LH[(size_t)bn * DLRU + c] = hst; }
}

template <bool APPLY>
__device__ __forceinline__ void s5_task(const Params& p, int l, int task, LAS unsigned char* wl, int lane) {
    unsigned char* ws = p.ws;
    const int g = task & 15, bn = task >> 4;
    const int tok0 = bn * CHUNK, fr = lane & 15, fq = lane >> 4;
    const bf16* Z = (const bf16*)(ws + WS_G);
    bf16* YS = (bf16*)(ws + WS_YS);
    const f4_t lzv = *(const f4_t*)((const float*)(ws + WS_SMALL + SM_LZ) + (size_t)((l * 16 + g) * 64 + lane) * 4);
    const float zr = lzv.x, zi = lzv.y;
    const bf16x8 zero8 = {0, 0, 0, 0, 0, 0, 0, 0};
    bf16x8 Bf[8];
    {
        const bf16* bc = (const bf16*)(ws + WS_SMALL + SM_BCAT) + (size_t)(l * 16 + g) * 128 * 16;
#pragma unroll
        for (int nt = 0; nt < 8; ++nt) Bf[nt] = (fq < 2) ? *(const bf16x8*)(bc + (16 * nt + fr) * 16 + 8 * fq) : zero8;
    }
    bf16x8 Cf[4]; float dsk = 0.f;
    if (APPLY) {
        const bf16* cc = (const bf16*)(ws + WS_SMALL + SM_CCAT) + (size_t)(l * 16 + g) * 16 * 128;
#pragma unroll
        for (int ks = 0; ks < 4; ++ks) Cf[ks] = *(const bf16x8*)(cc + fr * 128 + 32 * ks + 8 * fq);
        dsk = p.s_d[l * DSSM + 16 * g + fr];
    }
    float* SR = (float*)(ws + WS_CARRY + CA_SR); float* SI = (float*)(ws + WS_CARRY + CA_SI);
    const size_t cidx = (size_t)task * 64 + lane;
    float xr = APPLY ? SR[cidx] : 0.f, xi = APPLY ? SI[cidx] : 0.f;
    LAS float* Bu = (LAS float*)wl;
    LAS bf16* Xs = (LAS bf16*)(wl + 8448);
#pragma unroll 1
    for (int st = 0; st < 8; ++st) {
        const int t0 = tok0 + 16 * st;
        const bf16x8 A = (fq < 2) ? *(const bf16x8*)(Z + (size_t)(t0 + fr) * NIN + ZC_USSM + 16 * g + 8 * fq) : zero8;
#pragma unroll
        for (int nt = 0; nt < 8; ++nt) {
            f32x4 d = {0.f, 0.f, 0.f, 0.f};
            d = MFMA16(A, Bf[nt], d);
            LAS float* dst = Bu + (4 * fq) * 132 + 16 * nt + fr;
            dst[0] = d[0]; dst[132] = d[1]; dst[264] = d[2]; dst[396] = d[3];
        }
        WAVE_SYNC();
#pragma unroll
        for (int t = 0; t < 16; ++t) {
            const float bur = Bu[t * 132 + lane], bui = Bu[t * 132 + 64 + lane];
            const float nr = zr * xr - zi * xi + bur, ni = zr * xi + zi * xr + bui;
            xr = nr; xi = ni;
            if (APPLY) { Xs[t * 136 + lane] = (bf16)f2bf(xr); Xs[t * 136 + 64 + lane] = (bf16)f2bf(xi); }
        }
        if (APPLY) {
            WAVE_SYNC();
            f32x4 d = {0.f, 0.f, 0.f, 0.f};
#pragma unroll
            for (int ks = 0; ks < 4; ++ks) { const bf16x8 A2 = *(const LAS bf16x8*)(Xs + fr * 136 + 32 * ks + 8 * fq); d = MFMA16(A2, Cf[ks], d); }
#pragma unroll
            for (int j = 0; j < 4; ++j) {
                const int tok = t0 + 4 * fq + j;
                const float u = bf1(Z[(size_t)tok * NIN + ZC_USSM + 16 * g + fr]);
                YS[(size_t)tok * DSSM + 16 * g + fr] = (bf16)f2bf(fgelu(d[j] + dsk * u));
            }
        }
        WAVE_SYNC();
    }
    if (!APPLY) { SR[cidx] = xr; SI[cidx] = xi; }
}

template <bool KDECAY>
__device__ __forceinline__ void ret_stage(const Params& p, int tok0, int h, float l2g, LAS unsigned char* lds, int tid) {
    const bf16* Z = (const bf16*)(p.ws + WS_G);
#pragma unroll
    for (int i = 0; i < 2; ++i) {
        const int q = tid + 512 * i, row = q >> 3, ch = q & 7;
        const u32x4_t kv = *(const u32x4_t*)(Z + (size_t)(tok0 + row) * NIN + ZC_K + 64 * h + 8 * ch);
        const u32x4_t vv = *(const u32x4_t*)(Z + (size_t)(tok0 + row) * NIN + ZC_V + 64 * h + 8 * ch);
        if (KDECAY) { const float kd = exp2f(l2g * (float)(CHUNK - 1 - row)); *(LAS bf16x8*)(lds + row * 144 + ch * 16) = scale8(kv, kd); }
        else *(LAS u32x4_t*)(lds + row * 144 + ch * 16) = kv;
        *(LAS u32x4_t*)(lds + 18432 + row * 144 + ch * 16) = vv;
    }
}
__device__ __forceinline__ float ret_l2g(int h) { return log1pf(-exp2f(-5.f - (float)h)) * 1.4426950408889634f; }

__device__ __forceinline__ void ret_kv_task(const Params& p, int task, LAS unsigned char* lds, int tid, int lane, int wave) {
    const int h = task % 6, bn = task / 6, b = bn >> 6, n = bn & 63;
    const int tok0 = bn * CHUNK, fr = lane & 15, fq = lane >> 4;
    const float l2g = ret_l2g(h);
    ret_stage<true>(p, tok0, h, l2g, lds, tid);
    __syncthreads();
    const int et = wave >> 1, dt0 = 2 * (wave & 1);
    const int qp = fr >> 2, pp = fr & 3;
    f32x4 acc0 = {0.f, 0.f, 0.f, 0.f}, acc1 = {0.f, 0.f, 0.f, 0.f};
#pragma unroll
    for (int ks = 0; ks < 4; ++ks) {
        const int rowa = 32 * ks + 8 * fq + qp;
        LAS const unsigned char* vb = lds + 18432 + rowa * 144 + (16 * et + 4 * pp) * 2;
        const bf16x8 AV = tr8(vb, vb + 4 * 144);
        LAS const unsigned char* kb0 = lds + rowa * 144 + (16 * dt0 + 4 * pp) * 2;
        const bf16x8 BK0 = tr8(kb0, kb0 + 4 * 144), BK1 = tr8(kb0 + 32, kb0 + 32 + 4 * 144);
        acc0 = MFMA16(AV, BK0, acc0); acc1 = MFMA16(AV, BK1, acc1);
    }
    float* KV = (float*)(p.ws + WS_KV) + ((size_t)((b * 6 + h) * 64 + n)) * 4096;
#pragma unroll
    for (int j = 0; j < 4; ++j) { const int e = 16 * et + 4 * fq + j; KV[e * 64 + 16 * dt0 + fr] = acc0[j]; KV[e * 64 + 16 * dt0 + 16 + fr] = acc1[j]; }
    __syncthreads();
}

__device__ __forceinline__ void ret_out_task(const Params& p, int l, int task, LAS unsigned char* lds, int tid, int lane, int wave) {
    const int h = task % 6, bn = task / 6, b = bn >> 6, n = bn & 63;
    const int tok0 = bn * CHUNK, fr = lane & 15, fq = lane >> 4;
    const float l2g = ret_l2g(h);
    ret_stage<false>(p, tok0, h, l2g, lds, tid);
    const bf16* Z = (const bf16*)(p.ws + WS_G);
    bf16* Hb = (bf16*)(p.ws + WS_H);
    const int ql = 16 * wave + fr, tokq = tok0 + ql;
    const u32x4_t q0 = *(const u32x4_t*)(Z + (size_t)tokq * NIN + ZC_Q + 64 * h + 8 * fq), q1 = *(const u32x4_t*)(Z + (size_t)tokq * NIN + ZC_Q + 64 * h + 32 + 8 * fq);
    const bf16x8 Bq0 = __builtin_bit_cast(bf16x8, q0), Bq1 = __builtin_bit_cast(bf16x8, q1);
    const float qd = exp2f(l2g * (float)(ql + 1));
    const bf16x8 Bd0 = scale8(q0, qd), Bd1 = scale8(q1, qd);
    f32x4 accO[4];
    {
        const float* KV = (const float*)(p.ws + WS_KV) + ((size_t)((b * 6 + h) * 64 + n)) * 4096;
#pragma unroll
        for (int et = 0; et < 4; ++et) {
            const float* pr = KV + (16 * et + fr) * 64 + 8 * fq;
            const f32x4 a0 = *(const f32x4*)pr, a1 = *(const f32x4*)(pr + 4), a2 = *(const f32x4*)(pr + 32), a3 = *(const f32x4*)(pr + 36);
            f32x4 d = {0.f, 0.f, 0.f, 0.f};
            d = MFMA16(pack8(a0, a1), Bd0, d); d = MFMA16(pack8(a2, a3), Bd1, d);
            accO[et] = d;
        }
    }
    __syncthreads();
    const int qp = fr >> 2, pp = fr & 3;
    const int njb = (wave >> 1) + 1;
#pragma unroll 1
    for (int jb = 0; jb < njb; ++jb) {
        f32x4 St[2];
#pragma unroll
        for (int i = 0; i < 2; ++i) {
            const int kt = 2 * jb + i;
            LAS const unsigned char* kp = lds + (16 * kt + fr) * 144 + 16 * fq;
            const bf16x8 K0 = *(LAS const bf16x8*)kp, K1 = *(LAS const bf16x8*)(kp + 64);
            f32x4 d = {0.f, 0.f, 0.f, 0.f};
            d = MFMA16(K0, Bq0, d); d = MFMA16(K1, Bq1, d);
#pragma unroll
            for (int j = 0; j < 4; ++j) { const int diff = ql - (16 * kt + 4 * fq + j); d[j] = (diff >= 0) ? d[j] * exp2f(l2g * (float)diff) : 0.f; }
            St[i] = d;
        }
        const bf16x8 BS = pack8(St[0], St[1]);
        LAS const unsigned char* vb = lds + 18432 + (32 * jb + 4 * fq + qp) * 144 + (4 * pp) * 2;
#pragma unroll
        for (int et = 0; et < 4; ++et) { const bf16x8 AV = tr8(vb + 32 * et, vb + 32 * et + 16 * 144); accO[et] = MFMA16(AV, BS, accO[et]); }
    }
    float s = 0.f;
#pragma unroll
    for (int et = 0; et < 4; ++et) s += (accO[et][0] + accO[et][1]) + (accO[et][2] + accO[et][3]);
    s += __shfl_xor(s, 16); s += __shfl_xor(s, 32);
    const float mean = s * (1.f / 64.f); float s2 = 0.f;
#pragma unroll
    for (int et = 0; et < 4; ++et) { accO[et] = accO[et] - mean; s2 += (accO[et][0] * accO[et][0] + accO[et][1] * accO[et][1]) + (accO[et][2] * accO[et][2] + accO[et][3] * accO[et][3]); }
    s2 += __shfl_xor(s2, 16); s2 += __shfl_xor(s2, 32);
    const float rstd = 1.f / sqrtf(s2 * (1.f / 64.f) + LNEPS);
#pragma unroll
    for (int et = 0; et < 4; ++et) {
        const int e = 64 * h + 16 * et + 4 * fq;
        const f32x4 gg = *(const f32x4*)(p.gn_g + l * DRET + e), gb = *(const f32x4*)(p.gn_b + l * DRET + e);
        const u32x2_t gr = *(const u32x2_t*)(Z + (size_t)tokq * NIN + ZC_GRET + e);
        const f32x4 o = accO[et] * rstd * gg + gb;
        u32x2_t w; w.x = pk2(o[0] * fsilu(bflo(gr.x)), o[1] * fsilu(bfhi(gr.x))); w.y = pk2(o[2] * fsilu(bflo(gr.y)), o[3] * fsilu(bfhi(gr.y)));
        *(u32x2_t*)(Hb + (size_t)tokq * DM + DLRU + e) = w;
    }
    __syncthreads();
}

__device__ __forceinline__ void carry_phase(const Params& p, int l, int gt, int NT) {
    unsigned char* ws = p.ws;
    for (int idx = gt; idx < 98304 + 4096 + 1536; idx += NT) {
        if (idx < 98304) {
            const int bh = idx >> 12, ed = idx & 4095, h = bh % 6;
            const float cd = exp2f(ret_l2g(h) * 128.f);
            float* KV = (float*)(ws + WS_KV) + (size_t)bh * 64 * 4096 + ed;
            float st = 0.f;
#pragma unroll 8
            for (int n = 0; n < 64; ++n) { const float kv = KV[(size_t)n * 4096]; KV[(size_t)n * 4096] = st; st = cd * st + kv; }
        } else if (idx < 98304 + 4096) {
            const int i2 = idx - 98304, b = i2 >> 10, gp = i2 & 1023;
            const f4_t lzv = *(const f4_t*)((const float*)(ws + WS_SMALL + SM_LZ) + (size_t)(l * 1024 + gp) * 4);
            float* SR = (float*)(ws + WS_CARRY + CA_SR) + (size_t)b * 64 * 1024 + gp; float* SI = (float*)(ws + WS_CARRY + CA_SI) + (size_t)b * 64 * 1024 + gp;
            float xr = 0.f, xi = 0.f;
#pragma unroll 8
            for (int n = 0; n < 64; ++n) { const float er = SR[n * 1024], ei = SI[n * 1024]; SR[n * 1024] = xr; SI[n * 1024] = xi;
                const float nr = lzv.z * xr - lzv.w * xi + er, ni = lzv.z * xi + lzv.w * xr + ei; xr = nr; xi = ni; }
        } else {
            const int i2 = idx - 98304 - 4096, b = i2 / DLRU, c = i2 % DLRU;
            float* LA = (float*)(ws + WS_CARRY + CA_LA) + (size_t)b * 64 * DLRU + c; float* LH = (float*)(ws + WS_CARRY + CA_LH) + (size_t)b * 64 * DLRU + c;
            float hh = 0.f;
#pragma unroll 8
            for (int n = 0; n < 64; ++n) { const float a = LA[n * DLRU], e = LH[n * DLRU]; LH[n * DLRU] = hh; hh = a * hh + e; }
        }
    }
}

typedef const __attribute__((address_space(4))) Params* CP;
__device__ __forceinline__ const Params* fresh(CP q) { asm volatile("" : "+s"(q)); return (const Params*)q; }
__device__ __forceinline__ int fresh_tid(int wave_s) { int w = wave_s; unsigned z = 0; asm volatile("" : "+s"(w), "+s"(z)); return w * 64 + (int)__builtin_amdgcn_mbcnt_hi(~0u, __builtin_amdgcn_mbcnt_lo(~0u, z)); }
#define PH_BEGIN const Params& p = *fresh(pp); const int tid = fresh_tid(wave_s), lane = tid & 63, wave = __builtin_amdgcn_readfirstlane(tid >> 6); const int NBLK = gridDim.x, gw = blockIdx.x * 8 + wave, NGW = NBLK * 8; unsigned char* ws = p.ws; \
    float* X = (float*)(ws + WS_X); bf16* Hb = (bf16*)(ws + WS_H); bf16* G = (bf16*)(ws + WS_G); const float* mod = (const float*)(ws + WS_MOD); const unsigned char* wlay = ws + WS_W + (size_t)l * W_LAYER; const float* modl = mod + (size_t)l * NB_ * 9216; \
    LAS unsigned char* wl = lds + wave * 16384; (void)tid; (void)lane; (void)gw; (void)NGW; (void)X; (void)Hb; (void)G; (void)wlay; (void)modl; (void)wl;
#define GSYNC() cg::this_grid().sync()

template <int l>
__device__ __forceinline__ void layer_body(CP pp, LAS unsigned char* lds, int wave_s) {
        { PH_BEGIN pg8::Gemm g{Hb, (const bf16*)(wlay + WO_13A), MTOK, 2 * DFF, DM}; pg8::StaticOrder S; S.init(MTOK, 2 * DFF, NBLK, (int)blockIdx.x);
          pg8::EpiSwiglu E{G, DFF}; pg8::gemm_phase<pg8::EpiSwiglu, pg8::StaticOrder, true, true>(lds, g, S, E, tid); }
        GSYNC();
        { PH_BEGIN const float* xin = (l == 0) ? p.x : X;
          pg8::Gemm g{G, (const bf16*)(wlay + WO_2A), MTOK, DM, DFF}; pg8::StaticOrder S; S.init(MTOK, DM, NBLK, (int)blockIdx.x);
          pg8::EpiResid E{xin, X, modl + 2 * DM, 0.5f}; pg8::gemm_phase<pg8::EpiResid, pg8::StaticOrder, true, true>(lds, g, S, E, tid); }
        GSYNC();
        { PH_BEGIN ln_phase<true>(X, X, Hb, p.ln_g + (l * 3 + 0) * DM, p.ln_b + (l * 3 + 0) * DM, modl + 3 * DM, modl + 4 * DM, gw, NGW, lane); }
        GSYNC();
        { PH_BEGIN pg8::Gemm g{Hb, (const bf16*)(wlay + WO_IN), MTOK, NIN, DM}; pg8::StaticOrder S; S.init(MTOK, NIN, NBLK, (int)blockIdx.x);
          pg8::EpiZ E{G, (const float*)(ws + WS_TAB)}; pg8::gemm_phase<pg8::EpiZ, pg8::StaticOrder, true, true>(lds, g, S, E, tid); }
        GSYNC();
        { PH_BEGIN for (int t = blockIdx.x; t < 1536; t += NBLK) ret_kv_task(p, t, lds, tid, lane, wave); }
        { PH_BEGIN for (int t = gw; t < 1536; t += NGW) lru_task<false>(p, l, t, wl, lane); }
        { PH_BEGIN for (int t = gw; t < 4096; t += NGW) s5_task<false>(p, l, t, wl, lane); }
        GSYNC();
        { PH_BEGIN carry_phase(p, l, blockIdx.x * 512 + tid, NBLK * 512); }
        GSYNC();
        { PH_BEGIN for (int t = blockIdx.x; t < 1536; t += NBLK) ret_out_task(p, l, t, lds, tid, lane, wave); }
        { PH_BEGIN for (int t = gw; t < 1536; t += NGW) lru_task<true>(p, l, t, wl, lane); }
        { PH_BEGIN for (int t = gw; t < 4096; t += NGW) s5_task<true>(p, l, t, wl, lane); }
        GSYNC();
        { PH_BEGIN pg8::Gemm g{(const bf16*)(ws + WS_YS), (const bf16*)(ws + WS_SMALL + SM_WGLU) + (size_t)l * DSSM * DSSM, MTOK, DSSM, DSSM}; pg8::StaticOrder S; S.init(MTOK, DSSM, NBLK, (int)blockIdx.x);
          pg8::EpiGlu E{(const bf16*)(ws + WS_YS), Hb, p.s_bglu + l * DSSM}; pg8::gemm_phase<pg8::EpiGlu, pg8::StaticOrder, true, true>(lds, g, S, E, tid); }
        GSYNC();
        { PH_BEGIN pg8::Gemm g{Hb, (const bf16*)(wlay + WO_OUT), MTOK, DM, DM}; pg8::StaticOrder S; S.init(MTOK, DM, NBLK, (int)blockIdx.x);
          pg8::EpiResid E{X, X, modl + 5 * DM, 1.0f}; pg8::gemm_phase<pg8::EpiResid, pg8::StaticOrder, true, true>(lds, g, S, E, tid); }
        GSYNC();
        { PH_BEGIN ln_phase<true>(X, X, Hb, p.ln_g + (l * 3 + 1) * DM, p.ln_b + (l * 3 + 1) * DM, modl + 6 * DM, modl + 7 * DM, gw, NGW, lane); }
        GSYNC();
        { PH_BEGIN pg8::Gemm g{Hb, (const bf16*)(wlay + WO_13B), MTOK, 2 * DFF, DM}; pg8::StaticOrder S; S.init(MTOK, 2 * DFF, NBLK, (int)blockIdx.x);
          pg8::EpiSwiglu E{G, DFF}; pg8::gemm_phase<pg8::EpiSwiglu, pg8::StaticOrder, true, true>(lds, g, S, E, tid); }
        GSYNC();
        { PH_BEGIN pg8::Gemm g{G, (const bf16*)(wlay + WO_2B), MTOK, DM, DFF}; pg8::StaticOrder S; S.init(MTOK, DM, NBLK, (int)blockIdx.x);
          pg8::EpiResid E{X, X, modl + 8 * DM, 0.5f}; pg8::gemm_phase<pg8::EpiResid, pg8::StaticOrder, true, true>(lds, g, S, E, tid); }
        GSYNC();
        if (l == NLAYER - 1) {
            PH_BEGIN ln_phase<true>(X, p.out, nullptr, p.ln_g + (l * 3 + 2) * DM, p.ln_b + (l * 3 + 2) * DM, nullptr, nullptr, gw, NGW, lane);
        } else {
            { PH_BEGIN const float* modn = mod + (size_t)(l + 1) * NB_ * 9216;
              ln_phase<true>(X, X, Hb, p.ln_g + (l * 3 + 2) * DM, p.ln_b + (l * 3 + 2) * DM, modn + 0 * DM, modn + 1 * DM, gw, NGW, lane); }
        }
}

__global__ void __launch_bounds__(512, 2) mega_fwd(Params p_unused) {
    extern __shared__ __attribute__((aligned(16))) unsigned char lds_raw[];
    LAS unsigned char* lds = (LAS unsigned char*)lds_raw;
    CP pp = (CP)__builtin_amdgcn_kernarg_segment_ptr();
    const int wave_s = __builtin_amdgcn_readfirstlane(threadIdx.x >> 6);
    { const int l = 0; PH_BEGIN prologue(p, lds, tid, lane, wave, NBLK); }
    GSYNC();
    { const int l = 0; PH_BEGIN ln_phase<false>(p.x, nullptr, Hb, nullptr, nullptr, mod + 0 * DM, mod + 1 * DM, gw, NGW, lane); }
    GSYNC();
    layer_body<0>(pp, lds, wave_s);
    GSYNC();
    layer_body<1>(pp, lds, wave_s);
}

extern "C" void kernel_launch(void* const* d_in, const int* in_sizes, int n_in, void* d_out, int out_size, void* d_ws, size_t ws_size, hipStream_t stream) {
    static int grid_blocks = 0;
    if (grid_blocks == 0) {
        if (n_in != 34 || in_sizes[0] != MTOK * DM || out_size != MTOK * DM || ws_size < WS_END) {
            fprintf(stderr, "kernel_launch: unexpected shapes (n_in %d, in0 %d, out %d, ws %zu; need ws >= %zu); nothing launched\n", n_in, n_in > 0 ? in_sizes[0] : -1, out_size, ws_size, (size_t)WS_END);
            grid_blocks = -1; return;
        }
        int dev = 0, cus = 0, per_cu = 0;
        hipGetDevice(&dev);
        hipDeviceGetAttribute(&cus, hipDeviceAttributeMultiprocessorCount, dev);
        hipFuncSetAttribute((const void*)mega_fwd, hipFuncAttributeMaxDynamicSharedMemorySize, LDS_BYTES);
        hipOccupancyMaxActiveBlocksPerMultiprocessor(&per_cu, (const void*)mega_fwd, 512, LDS_BYTES);
        if (per_cu < 1) { fprintf(stderr, "kernel_launch: occupancy query returned %d\n", per_cu); per_cu = 1; }
        grid_blocks = cus * 1;
        (void)hipGetLastError();
    }
    if (grid_blocks < 0) return;
    hipMemsetAsync((unsigned char*)d_ws + WS_MOD, 0, MOD_BYTES, stream);
    Params p{};
    const float** fp = (const float**)&p;
    for (int i = 0; i < 34; ++i) fp[i] = (const float*)d_in[i];
    p.pos = (const int*)d_in[2];
    p.out = (float*)d_out; p.ws = (unsigned char*)d_ws;
    void* args[] = {&p};
    hipError_t e = hipLaunchCooperativeKernel((const void*)mega_fwd, dim3(grid_blocks), dim3(512), args, LDS_BYTES, stream);
    if (e != hipSuccess) fprintf(stderr, "cooperative launch failed: %s (grid %d)\n", hipGetErrorString(e), grid_blocks);
}
```

```cpp
#define PROBE 0
#include <hip/hip_runtime.h>
#include <hip/hip_cooperative_groups.h>
#include <cstdio>
#include <cstdint>
namespace cg = cooperative_groups;

#define LAS __attribute__((address_space(3)))
typedef unsigned short bf16;
typedef unsigned u32x4_t __attribute__((ext_vector_type(4)));
typedef unsigned u32x2_t __attribute__((ext_vector_type(2)));
typedef float f4_t __attribute__((ext_vector_type(4)));
typedef short s16x8_t __attribute__((ext_vector_type(8)));
typedef short s16x4_t __attribute__((ext_vector_type(4)));

constexpr int DM = 1024, NB_ = 4, SEQ = 8192, MTOK = NB_ * SEQ, NLAYER = 2, DFF = 2816, NIN = 2560;
constexpr int DLRU = 384, DRET = 384, DSSM = 256, NCH = 64, CHUNK = 128;
constexpr int ZC_ULRU = 0, ZC_GLRU = 384, ZC_Q = 768, ZC_K = 1152, ZC_V = 1536, ZC_GRET = 1920, ZC_USSM = 2304;
constexpr float ALPHA = 1.41421356237f, LNEPS = 1e-5f;

constexpr size_t MiB = 1u << 20;
constexpr size_t WS_MOD = 0, MOD_BYTES = (size_t)NLAYER * NB_ * 9 * DM * 4;
constexpr size_t WS_TAB = 1 * MiB;
constexpr size_t WS_SMALL = 9 * MiB;
constexpr size_t SM_WG = 0, SM_BCAT = 196608, SM_CCAT = 327680, SM_LZ = 458752, SM_WGLU = 524288;
constexpr size_t WS_W = 10 * MiB, W_LAYER = 40 * MiB;
constexpr size_t WO_13A = 0, WO_2A = 11 * MiB, WO_IN = 11 * MiB + 5632 * 1024, WO_OUT = WO_IN + 5 * MiB, WO_13B = WO_OUT + 2 * MiB, WO_2B = WO_13B + 11 * MiB;
constexpr size_t WS_CARRY = 90 * MiB, CA_LA = 0, CA_LH = 512 * 1024, CA_SR = 1 * MiB, CA_SI = 2 * MiB;
constexpr size_t WS_KV = 94 * MiB, WS_YS = 118 * MiB, WS_X = 134 * MiB, WS_H = 262 * MiB, WS_G = 326 * MiB, WS_END = 502 * MiB;
static_assert(WO_2B + 5632 * 1024 == W_LAYER, "weight map");

constexpr int LDS_BYTES = 131072 + 1024;

struct Params {
    const float* x; const float* c; const int* pos;
    const float* ada_w; const float* ada_b; const float* ln_g; const float* ln_b;
    const float* f1w1; const float* f1w3; const float* f1w2;
    const float* w_in; const float* conv_w; const float* conv_b;
    const float* lru_wa; const float* lru_ba; const float* lru_wx; const float* lru_bx; const float* lru_lam;
    const float* gn_g; const float* gn_b;
    const float* s_lre; const float* s_lim; const float* s_lstep; const float* s_bre; const float* s_bim; const float* s_cre; const float* s_cim; const float* s_d; const float* s_wglu; const float* s_bglu;
    const float* w_out; const float* f2w1; const float* f2w3; const float* f2w2;
    float* out; unsigned char* ws;
};

__device__ __forceinline__ unsigned f2bf(float f) { unsigned u = __builtin_bit_cast(unsigned, f); return (u + 0x7fffu + ((u >> 16) & 1u)) >> 16; }
__device__ __forceinline__ unsigned pk2(float lo, float hi) { return f2bf(lo) | (f2bf(hi) << 16); }
__device__ __forceinline__ float bflo(unsigned w) { return __uint_as_float(w << 16); }
__device__ __forceinline__ float bfhi(unsigned w) { return __uint_as_float(w & 0xffff0000u); }
__device__ __forceinline__ float bf1(bf16 h) { return __uint_as_float((unsigned)h << 16); }
__device__ __forceinline__ float fsigmoid(float x) { return __builtin_amdgcn_rcpf(1.f + __expf(-x)); }
__device__ __forceinline__ float fsilu(float x) { return x * fsigmoid(x); }
__device__ __forceinline__ float fgelu(float x) { return x * fsigmoid(1.5957691216f * (x + 0.044715f * x * x * x)); }
#define WAVE_SYNC() do { asm volatile("s_waitcnt lgkmcnt(0)" ::: "memory"); __builtin_amdgcn_wave_barrier(); asm volatile("" ::: "memory"); } while (0)

namespace pg8 {
#define PG8_LAS __attribute__((address_space(3)))
typedef unsigned short bf16_t;
typedef short bf16x8 __attribute__((ext_vector_type(8)));
typedef float f32x4 __attribute__((ext_vector_type(4)));
typedef unsigned u32x4 __attribute__((ext_vector_type(4)));
constexpr int BM = 256, BK = 64, HALF = 128, HTB = HALF * BK * 2  , STAGE_BYTES = 8 * HTB, NXCD = 8, WGM = 8;

__host__ __device__ __forceinline__ int lds_byte(int r, int c) { const int st = (r >> 4) * 2 + (c >> 5), rr = r & 15, cc = c & 31, ob = rr * 64 + cc * 2; return st * 1024 + (ob ^ (((ob >> 9) & 1) << 5)); }
__host__ __device__ __forceinline__ void stage_rc(int b, int& R, int& C) { const int st = b / 1024, sb = b % 1024, swz = sb ^ (((sb >> 9) & 1) << 5); R = (st >> 1) * 16 + swz / 64; C = (st & 1) * 32 + (swz % 64) / 2; }
__host__ __device__ __forceinline__ int perm32(int rho) { const int n = rho >> 4, i = rho & 15; return 8 * (i >> 2) + 4 * n + (i & 3); }

struct Unit { int pm, pn; };
struct Gemm { const bf16_t* A; const bf16_t* Bt; int M, N, K; };

struct StaticOrder {
    int nM, nN, nwg, G, c;
    __host__ __device__ void init(int M, int N, int G_, int c_) { nM = M / BM; nN = N / BM; nwg = nM * nN; G = G_; c = c_; }
    __host__ __device__ bool next(int i, Unit& u) const {
        const long L = (long)i * G + c; if (L >= nwg) return false;
        int wgid = (int)L; { const int q = nwg / NXCD, r = nwg % NXCD, xcd = wgid % NXCD, off = wgid / NXCD; wgid = (xcd < r ? xcd * (q + 1) : r * (q + 1) + (xcd - r) * q) + off; }
        const int nig = WGM * nN, gid = wgid / nig, fm = gid * WGM, gsz = (nM - fm) < WGM ? (nM - fm) : WGM;
        u.pm = fm + ((wgid % nig) % gsz); u.pn = (wgid % nig) / gsz; return true;
    }
    __device__ __forceinline__ void a_ready(const Unit&) const {}
    __device__ __forceinline__ void done(const Unit&) const {}
};

__device__ __forceinline__ unsigned cvt_pk_bf16(float lo, float hi) { unsigned r; asm volatile("v_cvt_pk_bf16_f32 %0, %1, %2" : "=v"(r) : "v"(lo), "v"(hi)); return r; }

struct EpiSwiglu {
    static constexpr bool PERM = true, AFTER_DRAIN = false;
    bf16_t* O; int ldo;
    __device__ __forceinline__ void operator()(const f32x4 (&acc)[2][2][4][2], const Unit& u, int wr, int wc, int fr, int fq) const {
        const int row0 = u.pm * BM + wr * 64 + fr, col0 = u.pn * HALF + wc * 32 + 8 * fq;
#pragma unroll
        for (int ai = 0; ai < 2; ++ai)
#pragma unroll
            for (int m = 0; m < 4; ++m) {
                bf16_t* rowp = O + (size_t)(row0 + ai * HALF + m * 16) * ldo + col0;
                const f32x4 g0 = acc[ai][0][m][0], g1 = acc[ai][0][m][1], u0 = acc[ai][1][m][0], u1 = acc[ai][1][m][1];
                u32x4 w;
                w.x = cvt_pk_bf16(fsilu(g0[0]) * u0[0], fsilu(g0[1]) * u0[1]); w.y = cvt_pk_bf16(fsilu(g0[2]) * u0[2], fsilu(g0[3]) * u0[3]);
                w.z = cvt_pk_bf16(fsilu(g1[0]) * u1[0], fsilu(g1[1]) * u1[1]); w.w = cvt_pk_bf16(fsilu(g1[2]) * u1[2], fsilu(g1[3]) * u1[3]);
                *(u32x4*)rowp = w;
            }
    }
};
struct EpiZ {
    static constexpr bool PERM = true, AFTER_DRAIN = false;
    bf16_t* O; const float* tab;
    __device__ __forceinline__ void operator()(const f32x4 (&acc)[2][2][4][2], const Unit& u, int wr, int wc, int fr, int fq) const {
        const int row0 = u.pm * BM + wr * 64 + fr, col0 = u.pn * BM + wc * 32 + 8 * fq;
        const bool rot = (u.pn >= 3 && u.pn <= 5);
#pragma unroll
        for (int ai = 0; ai < 2; ++ai)
#pragma unroll
            for (int m = 0; m < 4; ++m) {
                const int row = row0 + ai * HALF + m * 16;
#pragma unroll
                for (int bj = 0; bj < 2; ++bj) {
                    f32x4 v0 = acc[ai][bj][m][0], v1 = acc[ai][bj][m][1];
                    const int col = col0 + bj * HALF;
                    if (rot) {
                        const float* tp = tab + (size_t)row * 64 + (col & 63);
                        const f32x4 t0 = *(const f32x4*)tp, t1 = *(const f32x4*)(tp + 4);
                        f32x4 r0, r1;
                        r0[0] = v0[0] * t0[0] - v0[1] * t0[1]; r0[1] = v0[1] * t0[0] + v0[0] * t0[1];
                        r0[2] = v0[2] * t0[2] - v0[3] * t0[3]; r0[3] = v0[3] * t0[2] + v0[2] * t0[3];
                        r1[0] = v1[0] * t1[0] - v1[1] * t1[1]; r1[1] = v1[1] * t1[0] + v1[0] * t1[1];
                        r1[2] = v1[2] * t1[2] - v1[3] * t1[3]; r1[3] = v1[3] * t1[2] + v1[2] * t1[3];
                        v0 = r0; v1 = r1;
                    }
                    u32x4 w; w.x = cvt_pk_bf16(v0[0], v0[1]); w.y = cvt_pk_bf16(v0[2], v0[3]); w.z = cvt_pk_bf16(v1[0], v1[1]); w.w = cvt_pk_bf16(v1[2], v1[3]);
                    *(u32x4*)(O + (size_t)row * NIN + col) = w;
                }
            }
    }
};
struct EpiResid {
    static constexpr bool PERM = true, AFTER_DRAIN = false;
    const float* xin; float* out; const float* gate; float s;
    __device__ __forceinline__ void operator()(const f32x4 (&acc)[2][2][4][2], const Unit& u, int wr, int wc, int fr, int fq) const {
        const int row0 = u.pm * BM + wr * 64 + fr, col0 = u.pn * BM + wc * 32 + 8 * fq;
        const int b = (u.pm * BM) >> 13;
        f32x4 gv[2][2];
#pragma unroll
        for (int bj = 0; bj < 2; ++bj)
#pragma unroll
            for (int n = 0; n < 2; ++n) gv[bj][n] = *(const f32x4*)(gate + (size_t)b * 9216 + col0 + bj * HALF + 4 * n) * s;
#pragma unroll
        for (int ai = 0; ai < 2; ++ai)
#pragma unroll
            for (int m = 0; m < 4; ++m) {
                const size_t ro = (size_t)(row0 + ai * HALF + m * 16) * DM + col0;
#pragma unroll
                for (int bj = 0; bj < 2; ++bj)
#pragma unroll
                    for (int n = 0; n < 2; ++n) {
                        const f32x4 xi = *(const f32x4*)(xin + ro + bj * HALF + 4 * n);
                        *(f32x4*)(out + ro + bj * HALF + 4 * n) = xi * ALPHA + gv[bj][n] * acc[ai][bj][m][n];
                    }
            }
    }
};
struct EpiGlu {
    static constexpr bool PERM = true, AFTER_DRAIN = false;
    const bf16_t* YS; bf16_t* O; const float* bias;
    __device__ __forceinline__ void operator()(const f32x4 (&acc)[2][2][4][2], const Unit& u, int wr, int wc, int fr, int fq) const {
        const int row0 = u.pm * BM + wr * 64 + fr, col0 = wc * 32 + 8 * fq;
#pragma unroll
        for (int ai = 0; ai < 2; ++ai)
#pragma unroll
            for (int m = 0; m < 4; ++m) {
                const int row = row0 + ai * HALF + m * 16;
#pragma unroll
                for (int bj = 0; bj < 2; ++bj) {
                    const int col = col0 + bj * HALF;
                    const u32x4 yv = *(const u32x4*)(YS + (size_t)row * DSSM + col);
                    const f32x4 b0 = *(const f32x4*)(bias + col), b1 = *(const f32x4*)(bias + col + 4);
                    const f32x4 a0 = acc[ai][bj][m][0] + b0, a1 = acc[ai][bj][m][1] + b1;
                    u32x4 w;
                    w.x = cvt_pk_bf16(bflo(yv.x) * fsigmoid(a0[0]), bfhi(yv.x) * fsigmoid(a0[1])); w.y = cvt_pk_bf16(bflo(yv.y) * fsigmoid(a0[2]), bfhi(yv.y) * fsigmoid(a0[3]));
                    w.z = cvt_pk_bf16(bflo(yv.z) * fsigmoid(a1[0]), bfhi(yv.z) * fsigmoid(a1[1])); w.w = cvt_pk_bf16(bflo(yv.w) * fsigmoid(a1[2]), bfhi(yv.w) * fsigmoid(a1[3]));
                    *(u32x4*)(O + (size_t)row * DM + 768 + col) = w;
                }
            }
    }
};

template <class Epi, class Sched, bool ALIGN_EPI = false, bool SP2 = false>
__device__ __forceinline__ void gemm_phase(PG8_LAS unsigned char* lds, const Gemm g, const Sched& S, const Epi& E, const int tid) {
    const int wid = __builtin_amdgcn_readfirstlane(tid >> 6), lane = tid & 63, wr = wid >> 2, wc = wid & 3, fr = lane & 15, fq = lane >> 4;
    const int K = g.K, nt = K / BK;
    unsigned voffA[2], voffB[2];
#pragma unroll
    for (int i = 0; i < 2; ++i) { int R, C; stage_rc(tid * 16 + i * 8192, R, C); const int Rb = Epi::PERM ? ((R & ~31) + perm32(R & 31)) : R;
        voffA[i] = (unsigned)(R * K + C) * 2u; voffB[i] = (unsigned)(Rb * K + C) * 2u; }
    const size_t kstep = (size_t)(BK * 2);
    const size_t hstep = (size_t)HALF * K * 2;
    const size_t tstep = 2 * hstep;
    const unsigned ldsw = (unsigned)wid * 1024u;
    const int aoff = lds_byte(wr * 64 + fr, fq * 8), boff = lds_byte(wc * 32 + fr, fq * 8);
#define PG8_SA(b, h) (((b) * 2 + (h)) * HTB)
#define PG8_SB(b, h) ((4 + (b) * 2 + (h)) * HTB)
#define PG8_STAGE(bufoff, gbase, voff) do { _Pragma("unroll") for (int _i = 0; _i < 2; ++_i) \
        __builtin_amdgcn_global_load_lds((const unsigned*)((const char*)(gbase) + (voff)[_i]), (PG8_LAS unsigned*)(lds + (bufoff) + ldsw + _i * 8192), 16, 0, 0); } while (0)
#define PG8_LDA(dst, b, h) do { _Pragma("unroll") for (int m = 0; m < 4; ++m) _Pragma("unroll") for (int k = 0; k < 2; ++k) dst[m][k] = *(const PG8_LAS bf16x8*)(lds + PG8_SA(b, h) + aoff + m * 2048 + k * 1024); } while (0)
#define PG8_LDB(dst, b, h) do { _Pragma("unroll") for (int n = 0; n < 2; ++n) _Pragma("unroll") for (int k = 0; k < 2; ++k) dst[n][k] = *(const PG8_LAS bf16x8*)(lds + PG8_SB(b, h) + boff + n * 2048 + k * 1024); } while (0)
#define PG8_MMA(ai, bj, At, Bt) do { __builtin_amdgcn_s_setprio(1); _Pragma("unroll") for (int m = 0; m < 4; ++m) _Pragma("unroll") for (int n = 0; n < 2; ++n) _Pragma("unroll") for (int k = 0; k < 2; ++k) \
        acc[ai][bj][m][n] = __builtin_amdgcn_mfma_f32_16x16x32_bf16(Bt[n][k], At[m][k], acc[ai][bj][m][n], 0, 0, 0); __builtin_amdgcn_s_setprio(0); } while (0)
#define PG8_WAIT_V(n) asm volatile("s_waitcnt vmcnt(" #n ")" ::: "memory")
#define PG8_WAIT_L(n) asm volatile("s_waitcnt lgkmcnt(" #n ")" ::: "memory")
#define PG8_BAR __builtin_amdgcn_s_barrier()
#define PG8_SCHED __builtin_amdgcn_sched_barrier(0)
    Unit cur, nxt; int ui = 0;
    if (!S.next(0, cur)) return;
    f32x4 acc[2][2][4][2];
#pragma unroll
    for (int a = 0; a < 2; ++a)
#pragma unroll
        for (int b = 0; b < 2; ++b)
#pragma unroll
            for (int m = 0; m < 4; ++m)
#pragma unroll
                for (int n = 0; n < 2; ++n) acc[a][b][m][n] = (f32x4){0.f, 0.f, 0.f, 0.f};
    bf16x8 At[4][2], B0[2][2], B1[2][2];
    const char* cA = (const char*)g.A + (size_t)cur.pm * tstep; const char* cB = (const char*)g.Bt + (size_t)cur.pn * tstep;
    S.a_ready(cur);
    if constexpr (SP2) {
        PG8_STAGE(PG8_SB(0, 0), cB, voffB); PG8_STAGE(PG8_SB(0, 1), cB + hstep, voffB); PG8_STAGE(PG8_SA(0, 0), cA, voffA); PG8_STAGE(PG8_SA(0, 1), cA + hstep, voffA);
        if (wr == 1) PG8_BAR;
        PG8_WAIT_V(2); PG8_BAR;
        PG8_STAGE(PG8_SB(1, 0), cB + kstep, voffB); PG8_STAGE(PG8_SA(1, 0), cA + kstep, voffA); PG8_STAGE(PG8_SB(1, 1), cB + hstep + kstep, voffB);
        PG8_WAIT_V(6); PG8_BAR;
    } else {
        PG8_STAGE(PG8_SB(0, 0), cB, voffB); PG8_STAGE(PG8_SA(0, 0), cA, voffA); PG8_STAGE(PG8_SB(0, 1), cB + hstep, voffB); PG8_STAGE(PG8_SA(0, 1), cA + hstep, voffA);
        if (wr == 1) PG8_BAR;
        PG8_WAIT_V(4); PG8_BAR;
        PG8_STAGE(PG8_SB(1, 0), cB + kstep, voffB); PG8_STAGE(PG8_SA(1, 0), cA + kstep, voffA); PG8_STAGE(PG8_SB(1, 1), cB + hstep + kstep, voffB);
        PG8_WAIT_V(6); PG8_BAR;
    }
    for (;;) {
        const bool has_next = S.next(ui + 1, nxt);
        const char* nA = has_next ? (const char*)g.A + (size_t)nxt.pm * tstep : cA; const char* nB = has_next ? (const char*)g.Bt + (size_t)nxt.pn * tstep : cB;
        for (int t = 0; t < nt; t += 2) {
            const bool last = (t == nt - 2);
            const char* a1 = cA + (size_t)(t + 1) * kstep;
            const char* a2 = last ? nA : cA + (size_t)(t + 2) * kstep; const char* b2 = last ? nB : cB + (size_t)(t + 2) * kstep;
            const char* a3 = a2 + kstep; const char* b3 = b2 + kstep;
            if (last && has_next) S.a_ready(nxt);
            if constexpr (SP2) {
            PG8_LDB(B0, 0, 0); PG8_LDB(B1, 0, 1); PG8_SCHED; PG8_LDA(At, 0, 0); PG8_STAGE(PG8_SA(1, 1), a1 + hstep, voffA);
            PG8_WAIT_V(8); PG8_WAIT_L(0); PG8_BAR; PG8_MMA(0, 0, At, B0); PG8_MMA(0, 1, At, B1); PG8_BAR; PG8_SCHED;
            PG8_LDA(At, 0, 1); PG8_STAGE(PG8_SB(0, 0), b2, voffB); PG8_STAGE(PG8_SB(0, 1), b2 + hstep, voffB); PG8_STAGE(PG8_SA(0, 0), a2, voffA);
            PG8_WAIT_V(8); PG8_WAIT_L(0); PG8_BAR; PG8_MMA(1, 0, At, B0); PG8_MMA(1, 1, At, B1); PG8_BAR; PG8_SCHED;
            PG8_LDB(B0, 1, 0); PG8_LDB(B1, 1, 1); PG8_SCHED; PG8_LDA(At, 1, 0); PG8_STAGE(PG8_SA(0, 1), a2 + hstep, voffA);
            PG8_WAIT_V(8); PG8_WAIT_L(0); PG8_BAR; PG8_MMA(0, 0, At, B0); PG8_MMA(0, 1, At, B1); PG8_BAR; PG8_SCHED;
            PG8_LDA(At, 1, 1); PG8_STAGE(PG8_SB(1, 0), b3, voffB); PG8_STAGE(PG8_SB(1, 1), b3 + hstep, voffB); PG8_STAGE(PG8_SA(1, 0), a3, voffA);
            PG8_WAIT_V(8); PG8_WAIT_L(0); PG8_BAR; PG8_MMA(1, 0, At, B0); PG8_MMA(1, 1, At, B1); PG8_BAR; PG8_SCHED;
            } else {
            PG8_LDB(B0, 0, 0); PG8_SCHED; PG8_LDA(At, 0, 0); PG8_STAGE(PG8_SA(1, 1), a1 + hstep, voffA);
            PG8_WAIT_L(8); PG8_BAR; PG8_WAIT_L(0); PG8_MMA(0, 0, At, B0); PG8_BAR; PG8_SCHED;
            PG8_LDB(B1, 0, 1); PG8_STAGE(PG8_SB(0, 0), b2, voffB);
            PG8_BAR; PG8_WAIT_L(0); PG8_MMA(0, 1, At, B1); PG8_BAR;
            PG8_LDA(At, 0, 1); PG8_STAGE(PG8_SA(0, 0), a2, voffA);
            PG8_BAR; PG8_WAIT_L(0); PG8_MMA(1, 0, At, B0); PG8_BAR; PG8_SCHED;
            PG8_STAGE(PG8_SB(0, 1), b2 + hstep, voffB);
            PG8_WAIT_V(6); PG8_BAR; PG8_MMA(1, 1, At, B1); PG8_BAR;
            PG8_LDB(B0, 1, 0); PG8_SCHED; PG8_LDA(At, 1, 0); PG8_STAGE(PG8_SA(0, 1), a2 + hstep, voffA);
            PG8_WAIT_L(8); PG8_BAR; PG8_WAIT_L(0); PG8_MMA(0, 0, At, B0); PG8_BAR; PG8_SCHED;
            PG8_LDB(B1, 1, 1); PG8_STAGE(PG8_SB(1, 0), b3, voffB);
            PG8_BAR; PG8_WAIT_L(0); PG8_MMA(0, 1, At, B1); PG8_BAR;
            PG8_LDA(At, 1, 1); PG8_STAGE(PG8_SA(1, 0), a3, voffA);
            PG8_BAR; PG8_WAIT_L(0); PG8_MMA(1, 0, At, B0); PG8_BAR; PG8_SCHED;
            PG8_STAGE(PG8_SB(1, 1), b3 + hstep, voffB);
            PG8_WAIT_V(6); PG8_BAR; PG8_MMA(1, 1, At, B1); PG8_BAR;
            }
        }
        if constexpr (ALIGN_EPI) { if (wr == 0) PG8_BAR; }
        if constexpr (!Epi::AFTER_DRAIN) { E(acc, cur, wr, wc, fr, fq); S.done(cur); }
        if (!has_next) break;
#pragma unroll
        for (int a = 0; a < 2; ++a)
#pragma unroll
            for (int b = 0; b < 2; ++b)
#pragma unroll
                for (int m = 0; m < 4; ++m)
#pragma unroll
                    for (int n = 0; n < 2; ++n) acc[a][b][m][n] = (f32x4){0.f, 0.f, 0.f, 0.f};
        cur = nxt; cA = nA; cB = nB; ++ui;
        if constexpr (ALIGN_EPI) { if (wr == 1) PG8_BAR; }
    }
    PG8_WAIT_V(0);
    if constexpr (!ALIGN_EPI) { if (wr == 0) PG8_BAR; }
    PG8_BAR;
    if constexpr (Epi::AFTER_DRAIN) { E.fused(acc, cur, wr, wc, fr, fq, lds, wid, lane); S.done(cur); }
#undef PG8_SA
#undef PG8_SB
#undef PG8_STAGE
#undef PG8_LDA
#undef PG8_LDB
#undef PG8_MMA
#undef PG8_WAIT_V
#undef PG8_WAIT_L
#undef PG8_BAR
#undef PG8_SCHED
}
}

using pg8::f32x4;
typedef pg8::bf16x8 bf16x8;
#define MFMA16(a, b, c) __builtin_amdgcn_mfma_f32_16x16x32_bf16((a), (b), (c), 0, 0, 0)

__device__ __forceinline__ float wave_sum(float v) {
#pragma unroll
    for (int o = 1; o < 64; o <<= 1) v += __shfl_xor(v, o);
    return v;
}
__device__ __forceinline__ bf16x8 tr8(LAS const unsigned char* p0, LAS const unsigned char* p1) {
    const s16x4_t a = __builtin_amdgcn_ds_read_tr16_b64_v4i16((LAS s16x4_t*)p0);
    const s16x4_t b = __builtin_amdgcn_ds_read_tr16_b64_v4i16((LAS s16x4_t*)p1);
    return __builtin_shufflevector(a, b, 0, 1, 2, 3, 4, 5, 6, 7);
}
__device__ __forceinline__ bf16x8 pack8(f32x4 a, f32x4 b) {
    u32x4_t w; w.x = pk2(a[0], a[1]); w.y = pk2(a[2], a[3]); w.z = pk2(b[0], b[1]); w.w = pk2(b[2], b[3]);
    return __builtin_bit_cast(bf16x8, w);
}
__device__ __forceinline__ bf16x8 scale8(u32x4_t v, float s) {
    u32x4_t w; w.x = pk2(bflo(v.x) * s, bfhi(v.x) * s); w.y = pk2(bflo(v.y) * s, bfhi(v.y) * s); w.z = pk2(bflo(v.z) * s, bfhi(v.z) * s); w.w = pk2(bflo(v.w) * s, bfhi(v.w) * s);
    return __builtin_bit_cast(bf16x8, w);
}

__device__ __forceinline__ void tr_item(const float* W0, const float* W1, int K, int Nsrc, bf16* WT, int mode, LAS float* scr, int item, int nblk, int lane) {
    const int kb = item / nblk, nb = item % nblk, k0 = 64 * kb, n0 = 32 * nb;
    const int R = n0 + (lane & 31);
    const float* src = W0; int col = R; float sc = 1.f;
    if (mode == 1) { const int pn = R >> 8, bj = (R >> 7) & 1, cc = R & 127; src = bj ? W1 : W0; col = 128 * pn + cc; }
    else if (mode == 2) { if (R >= ZC_Q && R < ZC_V) { const int i = R & 63; col = (R & ~63) + (i >> 1) + 32 * (i & 1); if (R >= ZC_K) sc = 0.125f; } }
#pragma unroll
    for (int i = 0; i < 32; ++i) { const int kk = 2 * i + (lane >> 5); scr[kk * 33 + (lane & 31)] = src[(size_t)(k0 + kk) * Nsrc + col] * sc; }
    WAVE_SYNC();
    const int c = lane & 7;
#pragma unroll
    for (int j = 0; j < 4; ++j) { const int n = (lane >> 3) + 8 * j; const LAS float* s = scr + (8 * c) * 33 + n;
        u32x4_t o; o.x = pk2(s[0 * 33], s[1 * 33]); o.y = pk2(s[2 * 33], s[3 * 33]); o.z = pk2(s[4 * 33], s[5 * 33]); o.w = pk2(s[6 * 33], s[7 * 33]);
        *(u32x4_t*)(WT + (size_t)(n0 + n) * K + k0 + 8 * c) = o; }
    WAVE_SYNC();
}

__device__ __forceinline__ void prologue(const Params& p, LAS unsigned char* lds, int tid, int lane, int wave, int NBLK) {
    unsigned char* ws = p.ws;
    {
        LAS float* cond = (LAS float*)lds;
        for (int i = tid; i < NB_ * DM; i += 512) cond[i] = fsilu(p.c[i]);
        __syncthreads();
        float* mod = (float*)(ws + WS_MOD);
        for (int task = blockIdx.x; task < NLAYER * 18 * 16; task += NBLK) {
            const int l = task / 288, r = task % 288, jb = r / 16, ks = r % 16;
            const int j = jb * 512 + tid;
            const float* w = p.ada_w + (size_t)l * DM * 9216 + (size_t)(ks * 64) * 9216 + j;
            float a0 = 0.f, a1 = 0.f, a2 = 0.f, a3 = 0.f;
#pragma unroll 16
            for (int k = 0; k < 64; ++k) { const float wv = w[(size_t)k * 9216]; const int kk = ks * 64 + k;
                a0 += cond[kk] * wv; a1 += cond[DM + kk] * wv; a2 += cond[2 * DM + kk] * wv; a3 += cond[3 * DM + kk] * wv; }
            const float bb = (ks == 0) ? p.ada_b[l * 9216 + j] : 0.f;
            float* mo = mod + (size_t)l * NB_ * 9216 + j;
            atomicAdd(mo, a0 + bb); atomicAdd(mo + 9216, a1 + bb); atomicAdd(mo + 2 * 9216, a2 + bb); atomicAdd(mo + 3 * 9216, a3 + bb);
        }
        __syncthreads();
    }
    {
        LAS float* scr = (LAS float*)(lds + wave * 16384);
        const int gw = blockIdx.x * 8 + wave, NGW = NBLK * 8;
        constexpr int I13 = 16 * 176, I2 = 44 * 32, IIN = 16 * 80, IOUT = 16 * 32, IGLU = 4 * 8, IL = 2 * I13 + 2 * I2 + IIN + IOUT + IGLU;
        for (int it = gw; it < NLAYER * IL; it += NGW) {
            const int l = it / IL; int r = it % IL;
            unsigned char* wl = ws + WS_W + (size_t)l * W_LAYER;
            const size_t o13 = (size_t)l * DM * DFF, oin = (size_t)l * DM * NIN, oout = (size_t)l * DM * DM;
            if (r < I13) { tr_item(p.f1w1 + o13, p.f1w3 + o13, DM, DFF, (bf16*)(wl + WO_13A), 1, scr, r, 176, lane); continue; } r -= I13;
            if (r < I13) { tr_item(p.f2w1 + o13, p.f2w3 + o13, DM, DFF, (bf16*)(wl + WO_13B), 1, scr, r, 176, lane); continue; } r -= I13;
            if (r < I2) { tr_item(p.f1w2 + o13, nullptr, DFF, DM, (bf16*)(wl + WO_2A), 0, scr, r, 32, lane); continue; } r -= I2;
            if (r < I2) { tr_item(p.f2w2 + o13, nullptr, DFF, DM, (bf16*)(wl + WO_2B), 0, scr, r, 32, lane); continue; } r -= I2;
            if (r < IIN) { tr_item(p.w_in + oin, nullptr, DM, NIN, (bf16*)(wl + WO_IN), 2, scr, r, 80, lane); continue; } r -= IIN;
            if (r < IOUT) { tr_item(p.w_out + oout, nullptr, DM, DM, (bf16*)(wl + WO_OUT), 0, scr, r, 32, lane); continue; } r -= IOUT;
            tr_item(p.s_wglu + (size_t)l * DSSM * DSSM, nullptr, DSSM, DSSM, (bf16*)(ws + WS_SMALL + SM_WGLU) + (size_t)l * DSSM * DSSM, 0, scr, r, 8, lane);
        }
    }
    {
        const int gt = blockIdx.x * 512 + tid, NT = NBLK * 512;
        bf16* wg = (bf16*)(ws + WS_SMALL + SM_WG);
        for (int i = gt; i < NLAYER * 6 * 2 * 4096; i += NT) {
            const int ii = i & 63, jj = (i >> 6) & 63, gate = (i >> 12) & 1, lh = i >> 13;
            const float* src = gate ? p.lru_wx : p.lru_wa;
            wg[i] = (bf16)f2bf(src[(size_t)lh * 4096 + ii * 64 + jj]);
        }
        float* lz = (float*)(ws + WS_SMALL + SM_LZ); bf16* bc = (bf16*)(ws + WS_SMALL + SM_BCAT); bf16* cc = (bf16*)(ws + WS_SMALL + SM_CCAT);
        for (int i = gt; i < NLAYER * 16 * 64; i += NT) {
            const int pp = i & 63, lg = i >> 6;
            const float lr = p.s_lre[i], li = p.s_lim[i], dt = __expf(p.s_lstep[lg]);
            const float mag = __expf(lr * dt), zr = mag * cosf(li * dt), zi = mag * sinf(li * dt);
            const float den = lr * lr + li * li, er = ((zr - 1.f) * lr + zi * li) / den, ei = (zi * lr - (zr - 1.f) * li) / den;
            float pr = zr, pi = zi;
#pragma unroll
            for (int s = 0; s < 7; ++s) { const float nr = pr * pr - pi * pi, ni = 2.f * pr * pi; pr = nr; pi = ni; }
            lz[i * 4 + 0] = zr; lz[i * 4 + 1] = zi; lz[i * 4 + 2] = pr; lz[i * 4 + 3] = pi;
#pragma unroll
            for (int h = 0; h < 16; ++h) {
                const float br = p.s_bre[(size_t)i * 16 + h], bi = p.s_bim[(size_t)i * 16 + h];
                bc[((size_t)lg * 128 + pp) * 16 + h] = (bf16)f2bf(er * br - ei * bi);
                bc[((size_t)lg * 128 + 64 + pp) * 16 + h] = (bf16)f2bf(er * bi + ei * br);
            }
        }
        for (int i = gt; i < NLAYER * 16 * 16 * 64; i += NT) {
            const int pp = i & 63, lgh = i >> 6;
            cc[(size_t)lgh * 128 + pp] = (bf16)f2bf(p.s_cre[i]);
            cc[(size_t)lgh * 128 + 64 + pp] = (bf16)f2bf(-p.s_cim[i]);
        }
        float* tab = (float*)(ws + WS_TAB);
        for (int i = gt; i < MTOK * 32; i += NT) {
            const int f = i & 31, tok = i >> 5;
            const float inv = exp2f(-(float)f * (13.287712379549449f / 32.f));
            const float ang = (float)p.pos[tok] * inv;
            const double ad = (double)ang, nrev = __builtin_rint(ad * 0.15915494309189535);
            const float rr = (float)(ad - nrev * 6.283185307179586);
            tab[(size_t)i * 2] = cosf(rr); tab[(size_t)i * 2 + 1] = sinf(rr);
        }
    }
}

template <bool DO_LN>
__device__ __forceinline__ void ln_phase(const float* Y, float* Xout, bf16* Hout, const float* g, const float* bta, const float* sh, const float* sc, int gw, int NGW, int lane) {
    for (int m = gw; m < MTOK; m += NGW) {
        const f4_t* yr = (const f4_t*)(Y + (size_t)m * DM) + lane;
        f4_t v[4];
#pragma unroll
        for (int j = 0; j < 4; ++j) v[j] = yr[64 * j];
        if (DO_LN) {
            float s = 0.f;
#pragma unroll
            for (int j = 0; j < 4; ++j) s += (v[j].x + v[j].y) + (v[j].z + v[j].w);
            const float mean = wave_sum(s) * (1.f / DM); float s2 = 0.f;
#pragma unroll
            for (int j = 0; j < 4; ++j) { v[j] = v[j] - mean; s2 += (v[j].x * v[j].x + v[j].y * v[j].y) + (v[j].z * v[j].z + v[j].w * v[j].w); }
            const float rstd = 1.f / sqrtf(wave_sum(s2) * (1.f / DM) + LNEPS);
#pragma unroll
            for (int j = 0; j < 4; ++j) { const f4_t gg = ((const f4_t*)g)[lane + 64 * j], bb = ((const f4_t*)bta)[lane + 64 * j]; v[j] = v[j] * rstd * gg + bb; }
            if (Xout) {
                f4_t* xo = (f4_t*)(Xout + (size_t)m * DM) + lane;
#pragma unroll
                for (int j = 0; j < 4; ++j) xo[64 * j] = v[j];
            }
        }
        if (Hout) {
            const int b = m >> 13;
            const f4_t* shp = (const f4_t*)(sh + (size_t)b * 9216) + lane; const f4_t* scp = (const f4_t*)(sc + (size_t)b * 9216) + lane;
            u32x2_t* ho = (u32x2_t*)(Hout + (size_t)m * DM) + lane;
#pragma unroll
            for (int j = 0; j < 4; ++j) { const f4_t hv = v[j] * (scp[64 * j] + 1.f) + shp[64 * j]; u32x2_t o; o.x = pk2(hv.x, hv.y); o.y = pk2(hv.z, hv.w); ho[64 * j] = o; }
        }
    }
}

template <bool APPLY>
__device__ __forceinline__ void lru_task(const Params& p, int l, int task, LAS unsigned char* wl, int lane) {
    unsigned char* ws = p.ws;
    const int h = task % 6, bn = task / 6, n = bn & 63;
    const int tok0 = bn * CHUNK;
    const int c = h * 64 + lane, fr = lane & 15, fq = lane >> 4;
    const bf16* Z = (const bf16*)(ws + WS_G);
    bf16* Hb = (bf16*)(ws + WS_H);
    bf16 un[16], gn[16];
    {
        const bf16* zu = Z + (size_t)tok0 * NIN + ZC_ULRU + c;
#pragma unroll
        for (int t = 0; t < 16; ++t) un[t] = zu[(size_t)t * NIN];
        if (APPLY) {
#pragma unroll
            for (int t = 0; t < 16; ++t) gn[t] = zu[(size_t)t * NIN + (ZC_GLRU - ZC_ULRU)];
        }
    }
    float um3 = 0.f, um2 = 0.f, um1 = 0.f;
    if (n > 0) { um3 = bf1(Z[(size_t)(tok0 - 3) * NIN + ZC_ULRU + c]); um2 = bf1(Z[(size_t)(tok0 - 2) * NIN + ZC_ULRU + c]); um1 = bf1(Z[(size_t)(tok0 - 1) * NIN + ZC_ULRU + c]); }
    const float cw0 = p.conv_w[(l * 4 + 0) * DLRU + c], cw1 = p.conv_w[(l * 4 + 1) * DLRU + c], cw2 = p.conv_w[(l * 4 + 2) * DLRU + c], cw3 = p.conv_w[(l * 4 + 3) * DLRU + c];
    const float cb = p.conv_b[l * DLRU + c], ba = p.lru_ba[l * DLRU + c], bx = p.lru_bx[l * DLRU + c];
    const float sp8 = -8.f * log1pf(__expf(-p.lru_lam[l * DLRU + c]));
    bf16x8 Bw[2][4][2];
    {
        const bf16* wg = (const bf16*)(ws + WS_SMALL + SM_WG) + (size_t)(l * 6 + h) * 2 * 4096;
#pragma unroll
        for (int gt = 0; gt < 2; ++gt)
#pragma unroll
            for (int nt = 0; nt < 4; ++nt)
#pragma unroll
                for (int ks = 0; ks < 2; ++ks) Bw[gt][nt][ks] = *(const bf16x8*)(wg + gt * 4096 + (16 * nt + fr) * 64 + 32 * ks + 8 * fq);
    }
    float* LA = (float*)(ws + WS_CARRY + CA_LA); float* LH = (float*)(ws + WS_CARRY + CA_LH);
    float hst = APPLY ? LH[(size_t)bn * DLRU + c] : 0.f, ap = 1.f;
    LAS bf16* Auc = (LAS bf16*)wl;
    LAS float* Rb = (LAS float*)(wl + 2304);
    LAS float* Ib = (LAS float*)(wl + 2304 + 4352);
#pragma unroll 1
    for (int st = 0; st < 8; ++st) {
        const int t0 = tok0 + 16 * st;
        float uc[16], gg[16];
        {
            float ur[16];
#pragma unroll
            for (int t = 0; t < 16; ++t) { ur[t] = bf1(un[t]); if (APPLY) gg[t] = bf1(gn[t]); }
            const bf16* zu = Z + (size_t)(t0 + (st < 7 ? 16 : 0)) * NIN + ZC_ULRU + c;
#pragma unroll
            for (int t = 0; t < 16; ++t) un[t] = zu[(size_t)t * NIN];
            if (APPLY) {
#pragma unroll
                for (int t = 0; t < 16; ++t) gn[t] = zu[(size_t)t * NIN + (ZC_GLRU - ZC_ULRU)];
            }
#pragma unroll
            for (int t = 0; t < 16; ++t) {
                const float a3 = (t >= 3) ? ur[t >= 3 ? t - 3 : 0] : (t == 0 ? um3 : (t == 1 ? um2 : um1));
                const float a2 = (t >= 2) ? ur[t >= 2 ? t - 2 : 0] : (t == 0 ? um2 : um1);
                const float a1 = (t >= 1) ? ur[t >= 1 ? t - 1 : 0] : um1;
                uc[t] = cb + cw0 * a3 + cw1 * a2 + cw2 * a1 + cw3 * ur[t];
            }
            um3 = ur[13]; um2 = ur[14]; um1 = ur[15];
        }
#pragma unroll
        for (int t = 0; t < 16; ++t) Auc[t * 72 + lane] = (bf16)f2bf(uc[t]);
        WAVE_SYNC();
        {
            const bf16x8 A0 = *(const LAS bf16x8*)(Auc + fr * 72 + 8 * fq), A1 = *(const LAS bf16x8*)(Auc + fr * 72 + 32 + 8 * fq);
#pragma unroll
            for (int gt = 0; gt < 2; ++gt)
#pragma unroll
                for (int nt = 0; nt < 4; ++nt) {
                    f32x4 d = {0.f, 0.f, 0.f, 0.f};
                    d = MFMA16(A0, Bw[gt][nt][0], d); d = MFMA16(A1, Bw[gt][nt][1], d);
                    LAS float* dst = (gt ? Ib : Rb) + (4 * fq) * 68 + 16 * nt + fr;
                    dst[0] = d[0]; dst[68] = d[1]; dst[136] = d[2]; dst[204] = d[3];
                }
        }
        WAVE_SYNC();
#pragma unroll
        for (int t = 0; t < 16; ++t) {
            const float r = fsigmoid(Rb[t * 68 + lane] + ba), ig = fsigmoid(Ib[t * 68 + lane] + bx);
            const float a = __expf(sp8 * r);
            const float bt = sqrtf(fmaxf(1.f - a * a, 0.f)) * (ig * uc[t]);
            hst = a * hst + bt;
            if (APPLY) Hb[(size_t)(t0 + t) * DM + c] = (bf16)f2bf(hst * fgelu(gg[t]));
            else ap *= a;
        }
        WAVE_SYNC();
    }
    if (!APPLY) { LA[(size_t)bn * DLRU + c] = ap; LH[(size_t)bn * DLRU + c] = hst; }
}

template <bool APPLY>
__device__ __forceinline__ void s5_task(const Params& p, int l, int task, LAS unsigned char* wl, int lane) {
    unsigned char* ws = p.ws;
    const int g = task & 15, bn = task >> 4;
    const int tok0 = bn * CHUNK, fr = lane & 15, fq = lane >> 4;
    const bf16* Z = (const bf16*)(ws + WS_G);
    bf16* YS = (bf16*)(ws + WS_YS);
    const bf16x8 zero8 = {0, 0, 0, 0, 0, 0, 0, 0};
    bf16x8 Aall[8];
#pragma unroll
    for (int st = 0; st < 8; ++st) Aall[st] = (fq < 2) ? *(const bf16x8*)(Z + (size_t)(tok0 + 16 * st + fr) * NIN + ZC_USSM + 16 * g + 8 * fq) : zero8;
    const f4_t lzv = *(const f4_t*)((const float*)(ws + WS_SMALL + SM_LZ) + (size_t)((l * 16 + g) * 64 + lane) * 4);
    const float zr = lzv.x, zi = lzv.y;
    bf16x8 Bf[8];
    {
        const bf16* bc = (const bf16*)(ws + WS_SMALL + SM_BCAT) + (size_t)(l * 16 + g) * 128 * 16;
#pragma unroll
        for (int nt = 0; nt < 8; ++nt) Bf[nt] = (fq < 2) ? *(const bf16x8*)(bc + (16 * nt + fr) * 16 + 8 * fq) : zero8;
    }
    bf16x8 Cf[4], Df = zero8;
    if (APPLY) {
        const bf16* cc = (const bf16*)(ws + WS_SMALL + SM_CCAT) + (size_t)(l * 16 + g) * 16 * 128;
#pragma unroll
        for (int ks = 0; ks < 4; ++ks) Cf[ks] = *(const bf16x8*)(cc + fr * 128 + 32 * ks + 8 * fq);
        const short dv = (short)f2bf(p.s_d[l * DSSM + 16 * g + fr]);
#pragma unroll
        for (int j = 0; j < 8; ++j) Df[j] = (8 * fq + j == fr) ? dv : (short)0;
    }
    float* SR = (float*)(ws + WS_CARRY + CA_SR); float* SI = (float*)(ws + WS_CARRY + CA_SI);
    const size_t cidx = (size_t)task * 64 + lane;
    float xr = APPLY ? SR[cidx] : 0.f, xi = APPLY ? SI[cidx] : 0.f;
    LAS float* Bu = (LAS float*)wl;
    LAS bf16* Xs = (LAS bf16*)(wl + 8448);
#pragma unroll
    for (int st = 0; st < 8; ++st) {
        const int t0 = tok0 + 16 * st;
        const bf16x8 A = Aall[st];
#pragma unroll
        for (int nt = 0; nt < 8; ++nt) {
            f32x4 d = {0.f, 0.f, 0.f, 0.f};
            d = MFMA16(A, Bf[nt], d);
            LAS float* dst = Bu + (4 * fq) * 132 + 16 * nt + fr;
            dst[0] = d[0]; dst[132] = d[1]; dst[264] = d[2]; dst[396] = d[3];
        }
        WAVE_SYNC();
#pragma unroll
        for (int t = 0; t < 16; ++t) {
            const float bur = Bu[t * 132 + lane], bui = Bu[t * 132 + 64 + lane];
            const float nr = zr * xr - zi * xi + bur, ni = zr * xi + zi * xr + bui;
            xr = nr; xi = ni;
            if (APPLY) { Xs[t * 136 + lane] = (bf16)f2bf(xr); Xs[t * 136 + 64 + lane] = (bf16)f2bf(xi); }
        }
        if (APPLY) {
            WAVE_SYNC();
            f32x4 d = {0.f, 0.f, 0.f, 0.f};
            d = MFMA16(A, Df, d);
#pragma unroll
            for (int ks = 0; ks < 4; ++ks) { const bf16x8 A2 = *(const LAS bf16x8*)(Xs + fr * 136 + 32 * ks + 8 * fq); d = MFMA16(A2, Cf[ks], d); }
#pragma unroll
            for (int j = 0; j < 4; ++j) YS[(size_t)(t0 + 4 * fq + j) * DSSM + 16 * g + fr] = (bf16)f2bf(fgelu(d[j]));
        }
        WAVE_SYNC();
    }
    if (!APPLY) { SR[cidx] = xr; SI[cidx] = xi; }
}

__device__ __forceinline__ float ret_l2g(int h) { return log1pf(-exp2f(-5.f - (float)h)) * 1.4426950408889634f; }
struct RetRegs { u32x4_t k[2][2], v[2][2]; };
__device__ __forceinline__ void ret_fetch(const Params& p, int task, int tid, RetRegs& R) {
    const bf16* Z = (const bf16*)(p.ws + WS_G);
    const int hp = task % 3, bn = task / 3, tok0 = bn * CHUNK;
#pragma unroll
    for (int hh = 0; hh < 2; ++hh)
#pragma unroll
        for (int i = 0; i < 2; ++i) {
            const int q = tid + 512 * i, row = q >> 3, ch = q & 7;
            const bf16* zp = Z + (size_t)(tok0 + row) * NIN + 64 * (2 * hp + hh) + 8 * ch;
            R.k[hh][i] = *(const u32x4_t*)(zp + ZC_K); R.v[hh][i] = *(const u32x4_t*)(zp + ZC_V);
        }
}
template <bool KDECAY>
__device__ __forceinline__ void ret_put(const RetRegs& R, int hp, LAS unsigned char* lds, int tid) {
#pragma unroll
    for (int hh = 0; hh < 2; ++hh)
#pragma unroll
        for (int i = 0; i < 2; ++i) {
            const int q = tid + 512 * i, row = q >> 3, ch = q & 7;
            LAS unsigned char* dst = lds + hh * 36864 + row * 144 + ch * 16;
            if (KDECAY) { const float kd = exp2f(ret_l2g(2 * hp + hh) * (float)(CHUNK - 1 - row)); *(LAS bf16x8*)dst = scale8(R.k[hh][i], kd); }
            else *(LAS u32x4_t*)dst = R.k[hh][i];
            *(LAS u32x4_t*)(dst + 18432) = R.v[hh][i];
        }
}

__device__ __forceinline__ void ret_kv_compute(const Params& p, int task, LAS unsigned char* lds, int lane, int wave) {
    const int hp = task % 3, bn = task / 3, b = bn >> 6, n = bn & 63;
    const int fr = lane & 15, fq = lane >> 4;
    const int et = wave >> 1, dt0 = 2 * (wave & 1);
    const int qp = fr >> 2, pp = fr & 3;
#pragma unroll
    for (int hh = 0; hh < 2; ++hh) {
        const int h = 2 * hp + hh;
        LAS const unsigned char* img = lds + hh * 36864;
        f32x4 acc0 = {0.f, 0.f, 0.f, 0.f}, acc1 = {0.f, 0.f, 0.f, 0.f};
#pragma unroll
        for (int ks = 0; ks < 4; ++ks) {
            const int rowa = 32 * ks + 8 * fq + qp;
            LAS const unsigned char* vb = img + 18432 + rowa * 144 + (16 * et + 4 * pp) * 2;
            const bf16x8 AV = tr8(vb, vb + 4 * 144);
            LAS const unsigned char* kb0 = img + rowa * 144 + (16 * dt0 + 4 * pp) * 2;
            const bf16x8 BK0 = tr8(kb0, kb0 + 4 * 144), BK1 = tr8(kb0 + 32, kb0 + 32 + 4 * 144);
            acc0 = MFMA16(AV, BK0, acc0); acc1 = MFMA16(AV, BK1, acc1);
        }
        float* KV = (float*)(p.ws + WS_KV) + ((size_t)((b * 6 + h) * 64 + n)) * 4096;
#pragma unroll
        for (int j = 0; j < 4; ++j) { const int e = 16 * et + 4 * fq + j; KV[e * 64 + 16 * dt0 + fr] = acc0[j]; KV[e * 64 + 16 * dt0 + 16 + fr] = acc1[j]; }
    }
}

__device__ __forceinline__ void ret_out_tile(const Params& p, int l, int bn, int h, int qt, LAS const unsigned char* img, int lane) {
    const int b = bn >> 6, n = bn & 63, tok0 = bn * CHUNK, fr = lane & 15, fq = lane >> 4;
    const float l2g = ret_l2g(h);
    const bf16* Z = (const bf16*)(p.ws + WS_G);
    bf16* Hb = (bf16*)(p.ws + WS_H);
    const int ql = 16 * qt + fr, tokq = tok0 + ql;
    const u32x4_t q0 = *(const u32x4_t*)(Z + (size_t)tokq * NIN + ZC_Q + 64 * h + 8 * fq), q1 = *(const u32x4_t*)(Z + (size_t)tokq * NIN + ZC_Q + 64 * h + 32 + 8 * fq);
    u32x2_t gr[4];
#pragma unroll
    for (int et = 0; et < 4; ++et) gr[et] = *(const u32x2_t*)(Z + (size_t)tokq * NIN + ZC_GRET + 64 * h + 16 * et + 4 * fq);
    const bf16x8 Bq0 = __builtin_bit_cast(bf16x8, q0), Bq1 = __builtin_bit_cast(bf16x8, q1);
    const float qd = exp2f(l2g * (float)(ql + 1));
    const bf16x8 Bd0 = scale8(q0, qd), Bd1 = scale8(q1, qd);
    f32x4 accO[4];
    {
        const float* KV = (const float*)(p.ws + WS_KV) + ((size_t)((b * 6 + h) * 64 + n)) * 4096;
#pragma unroll
        for (int et = 0; et < 4; ++et) {
            const float* pr = KV + (16 * et + fr) * 64 + 8 * fq;
            const f32x4 a0 = *(const f32x4*)pr, a1 = *(const f32x4*)(pr + 4), a2 = *(const f32x4*)(pr + 32), a3 = *(const f32x4*)(pr + 36);
            f32x4 d = {0.f, 0.f, 0.f, 0.f};
            d = MFMA16(pack8(a0, a1), Bd0, d); d = MFMA16(pack8(a2, a3), Bd1, d);
            accO[et] = d;
        }
    }
    const int qp = fr >> 2, pp = fr & 3;
    const int njb = (qt >> 1) + 1;
#pragma unroll 1
    for (int jb = 0; jb < njb; ++jb) {
        f32x4 St[2];
#pragma unroll
        for (int i = 0; i < 2; ++i) {
            const int kt = 2 * jb + i;
            LAS const unsigned char* kp = img + (16 * kt + fr) * 144 + 16 * fq;
            const bf16x8 K0 = *(LAS const bf16x8*)kp, K1 = *(LAS const bf16x8*)(kp + 64);
            f32x4 d = {0.f, 0.f, 0.f, 0.f};
            d = MFMA16(K0, Bq0, d); d = MFMA16(K1, Bq1, d);
#pragma unroll
            for (int j = 0; j < 4; ++j) { const int diff = ql - (16 * kt + 4 * fq + j); d[j] = (diff >= 0) ? d[j] * exp2f(l2g * (float)diff) : 0.f; }
            St[i] = d;
        }
        const bf16x8 BS = pack8(St[0], St[1]);
        LAS const unsigned char* vb = img + 18432 + (32 * jb + 4 * fq + qp) * 144 + (4 * pp) * 2;
#pragma unroll
        for (int et = 0; et < 4; ++et) { const bf16x8 AV = tr8(vb + 32 * et, vb + 32 * et + 16 * 144); accO[et] = MFMA16(AV, BS, accO[et]); }
    }
    float s = 0.f;
#pragma unroll
    for (int et = 0; et < 4; ++et) s += (accO[et][0] + accO[et][1]) + (accO[et][2] + accO[et][3]);
    s += __shfl_xor(s, 16); s += __shfl_xor(s, 32);
    const float mean = s * (1.f / 64.f); float s2 = 0.f;
#pragma unroll
    for (int et = 0; et < 4; ++et) { accO[et] = accO[et] - mean; s2 += (accO[et][0] * accO[et][0] + accO[et][1] * accO[et][1]) + (accO[et][2] * accO[et][2] + accO[et][3] * accO[et][3]); }
    s2 += __shfl_xor(s2, 16); s2 += __shfl_xor(s2, 32);
    const float rstd = 1.f / sqrtf(s2 * (1.f / 64.f) + LNEPS);
#pragma unroll
    for (int et = 0; et < 4; ++et) {
        const int e = 64 * h + 16 * et + 4 * fq;
        const f32x4 gg = *(const f32x4*)(p.gn_g + l * DRET + e), gb = *(const f32x4*)(p.gn_b + l * DRET + e);
        const f32x4 o = accO[et] * rstd * gg + gb;
        u32x2_t w; w.x = pk2(o[0] * fsilu(bflo(gr[et].x)), o[1] * fsilu(bfhi(gr[et].x))); w.y = pk2(o[2] * fsilu(bflo(gr[et].y)), o[3] * fsilu(bfhi(gr[et].y)));
        *(u32x2_t*)(Hb + (size_t)tokq * DM + DLRU + e) = w;
    }
}

template <bool OUT>
__device__ __forceinline__ void ret_phase(const Params& p, int l, LAS unsigned char* lds, int tid, int lane, int wave, int NBLK) {
    int task = blockIdx.x;
    if (task >= 768) return;
    RetRegs R; ret_fetch(p, task, tid, R);
    for (; task < 768; task += NBLK) {
        const int hp = task % 3, bn = task / 3;
        ret_put<!OUT>(R, hp, lds, tid);
        const int nxt = task + NBLK;
        if (nxt < 768) ret_fetch(p, nxt, tid, R);
        __syncthreads();
        if (OUT) {
            ret_out_tile(p, l, bn, 2 * hp, wave, lds, lane);
            ret_out_tile(p, l, bn, 2 * hp + 1, 7 - wave, lds + 36864, lane);
        } else ret_kv_compute(p, task, lds, lane, wave);
        __syncthreads();
    }
}

__device__ __forceinline__ void carry_phase(const Params& p, int l, int gt, int NT) {
    unsigned char* ws = p.ws;
    for (int idx = gt; idx < 98304 + 4096 + 1536; idx += NT) {
        if (idx < 98304) {
            const int bh = idx >> 12, ed = idx & 4095, h = bh % 6;
            const float cd = exp2f(ret_l2g(h) * 128.f);
            float* KV = (float*)(ws + WS_KV) + (size_t)bh * 64 * 4096 + ed;
            float st = 0.f;
#pragma unroll 8
            for (int n = 0; n < 64; ++n) { const float kv = KV[(size_t)n * 4096]; KV[(size_t)n * 4096] = st; st = cd * st + kv; }
        } else if (idx < 98304 + 4096) {
            const int i2 = idx - 98304, b = i2 >> 10, gp = i2 & 1023;
            const f4_t lzv = *(const f4_t*)((const float*)(ws + WS_SMALL + SM_LZ) + (size_t)(l * 1024 + gp) * 4);
            float* SR = (float*)(ws + WS_CARRY + CA_SR) + (size_t)b * 64 * 1024 + gp; float* SI = (float*)(ws + WS_CARRY + CA_SI) + (size_t)b * 64 * 1024 + gp;
            float xr = 0.f, xi = 0.f;
#pragma unroll 8
            for (int n = 0; n < 64; ++n) { const float er = SR[n * 1024], ei = SI[n * 1024]; SR[n * 1024] = xr; SI[n * 1024] = xi;
                const float nr = lzv.z * xr - lzv.w * xi + er, ni = lzv.z * xi + lzv.w * xr + ei; xr = nr; xi = ni; }
        } else {
            const int i2 = idx - 98304 - 4096, b = i2 / DLRU, c = i2 % DLRU;
            float* LA = (float*)(ws + WS_CARRY + CA_LA) + (size_t)b * 64 * DLRU + c; float* LH = (float*)(ws + WS_CARRY + CA_LH) + (size_t)b * 64 * DLRU + c;
            float hh = 0.f;
#pragma unroll 8
            for (int n = 0; n < 64; ++n) { const float a = LA[n * DLRU], e = LH[n * DLRU]; LH[n * DLRU] = hh; hh = a * hh + e; }
        }
    }
}

typedef const __attribute__((address_space(4))) Params* CP;
__device__ __forceinline__ const Params* fresh(CP q) { asm volatile("" : "+s"(q)); return (const Params*)q; }
__device__ __forceinline__ int fresh_tid(int wave_s) { int w = wave_s; unsigned z = 0; asm volatile("" : "+s"(w), "+s"(z)); return w * 64 + (int)__builtin_amdgcn_mbcnt_hi(~0u, __builtin_amdgcn_mbcnt_lo(~0u, z)); }
#define PH_BEGIN const Params& p = *fresh(pp); const int tid = fresh_tid(wave_s), lane = tid & 63, wave = __builtin_amdgcn_readfirstlane(tid >> 6); const int NBLK = gridDim.x, gw = blockIdx.x * 8 + wave, NGW = NBLK * 8; unsigned char* ws = p.ws; \
    float* X = (float*)(ws + WS_X); bf16* Hb = (bf16*)(ws + WS_H); bf16* G = (bf16*)(ws + WS_G); const float* mod = (const float*)(ws + WS_MOD); const unsigned char* wlay = ws + WS_W + (size_t)l * W_LAYER; const float* modl = mod + (size_t)l * NB_ * 9216; \
    LAS unsigned char* wl = lds + wave * 16384; (void)tid; (void)lane; (void)gw; (void)NGW; (void)X; (void)Hb; (void)G; (void)wlay; (void)modl; (void)wl;
#define GSYNC() cg::this_grid().sync()
#ifndef PROBE
#define PROBE 0
#endif

template <int l>
__device__ __forceinline__ void layer_body(CP pp, LAS unsigned char* lds, int wave_s) {
        { PH_BEGIN pg8::Gemm g{Hb, (const bf16*)(wlay + WO_13A), MTOK, 2 * DFF, DM}; pg8::StaticOrder S; S.init(MTOK, 2 * DFF, NBLK, (int)blockIdx.x);
          pg8::EpiSwiglu E{G, DFF}; pg8::gemm_phase<pg8::EpiSwiglu, pg8::StaticOrder, true, true>(lds, g, S, E, tid);
          if (PROBE == 1) { GSYNC(); pg8::gemm_phase<pg8::EpiSwiglu, pg8::StaticOrder, true, true>(lds, g, S, E, tid); } }
        GSYNC();
        { PH_BEGIN const float* xin = (l == 0) ? p.x : X;
          pg8::Gemm g{G, (const bf16*)(wlay + WO_2A), MTOK, DM, DFF}; pg8::StaticOrder S; S.init(MTOK, DM, NBLK, (int)blockIdx.x);
          pg8::EpiResid E{xin, X, modl + 2 * DM, 0.5f}; pg8::gemm_phase<pg8::EpiResid, pg8::StaticOrder, true, true>(lds, g, S, E, tid); }
        GSYNC();
        { PH_BEGIN ln_phase<true>(X, X, Hb, p.ln_g + (l * 3 + 0) * DM, p.ln_b + (l * 3 + 0) * DM, modl + 3 * DM, modl + 4 * DM, gw, NGW, lane); }
        GSYNC();
        { PH_BEGIN pg8::Gemm g{Hb, (const bf16*)(wlay + WO_IN), MTOK, NIN, DM}; pg8::StaticOrder S; S.init(MTOK, NIN, NBLK, (int)blockIdx.x);
          pg8::EpiZ E{G, (const float*)(ws + WS_TAB)}; pg8::gemm_phase<pg8::EpiZ, pg8::StaticOrder, true, true>(lds, g, S, E, tid);
          if (PROBE == 1) { GSYNC(); pg8::gemm_phase<pg8::EpiZ, pg8::StaticOrder, true, true>(lds, g, S, E, tid); } }
        GSYNC();
        { PH_BEGIN ret_phase<false>(p, l, lds, tid, lane, wave, NBLK); }
        { PH_BEGIN for (int t = gw; t < 1536; t += NGW) lru_task<false>(p, l, t, wl, lane); }
        { PH_BEGIN for (int t = gw; t < 4096; t += NGW) s5_task<false>(p, l, t, wl, lane); }
        if (PROBE == 2) { GSYNC();
        { PH_BEGIN ret_phase<false>(p, l, lds, tid, lane, wave, NBLK); }
        { PH_BEGIN for (int t = gw; t < 1536; t += NGW) lru_task<false>(p, l, t, wl, lane); }
        { PH_BEGIN for (int t = gw; t < 4096; t += NGW) s5_task<false>(p, l, t, wl, lane); } }
        GSYNC();
        { PH_BEGIN carry_phase(p, l, blockIdx.x * 512 + tid, NBLK * 512); }
        GSYNC();
        { PH_BEGIN ret_phase<true>(p, l, lds, tid, lane, wave, NBLK); }
        { PH_BEGIN for (int t = gw; t < 1536; t += NGW) lru_task<true>(p, l, t, wl, lane); }
        { PH_BEGIN for (int t = gw; t < 4096; t += NGW) s5_task<true>(p, l, t, wl, lane); }
        if (PROBE == 2) { GSYNC();
        { PH_BEGIN ret_phase<true>(p, l, lds, tid, lane, wave, NBLK); }
        { PH_BEGIN for (int t = gw; t < 1536; t += NGW) lru_task<true>(p, l, t, wl, lane); }
        { PH_BEGIN for (int t = gw; t < 4096; t += NGW) s5_task<true>(p, l, t, wl, lane); } }
        GSYNC();
        { PH_BEGIN pg8::Gemm g{(const bf16*)(ws + WS_YS), (const bf16*)(ws + WS_SMALL + SM_WGLU) + (size_t)l * DSSM * DSSM, MTOK, DSSM, DSSM}; pg8::StaticOrder S; S.init(MTOK, DSSM, NBLK, (int)blockIdx.x);
          pg8::EpiGlu E{(const bf16*)(ws + WS_YS), Hb, p.s_bglu + l * DSSM}; pg8::gemm_phase<pg8::EpiGlu, pg8::StaticOrder, true, true>(lds, g, S, E, tid); }
        GSYNC();
        { PH_BEGIN pg8::Gemm g{Hb, (const bf16*)(wlay + WO_OUT), MTOK, DM, DM}; pg8::StaticOrder S; S.init(MTOK, DM, NBLK, (int)blockIdx.x);
          pg8::EpiResid E{X, X, modl + 5 * DM, 1.0f}; pg8::gemm_phase<pg8::EpiResid, pg8::StaticOrder, true, true>(lds, g, S, E, tid); }
        GSYNC();
        { PH_BEGIN ln_phase<true>(X, X, Hb, p.ln_g + (l * 3 + 1) * DM, p.ln_b + (l * 3 + 1) * DM, modl + 6 * DM, modl + 7 * DM, gw, NGW, lane); }
        GSYNC();
        { PH_BEGIN pg8::Gemm g{Hb, (const bf16*)(wlay + WO_13B), MTOK, 2 * DFF, DM}; pg8::StaticOrder S; S.init(MTOK, 2 * DFF, NBLK, (int)blockIdx.x);
          pg8::EpiSwiglu E{G, DFF}; pg8::gemm_phase<pg8::EpiSwiglu, pg8::StaticOrder, true, true>(lds, g, S, E, tid); }
        GSYNC();
        { PH_BEGIN pg8::Gemm g{G, (const bf16*)(wlay + WO_2B), MTOK, DM, DFF}; pg8::StaticOrder S; S.init(MTOK, DM, NBLK, (int)blockIdx.x);
          pg8::EpiResid E{X, X, modl + 8 * DM, 0.5f}; pg8::gemm_phase<pg8::EpiResid, pg8::StaticOrder, true, true>(lds, g, S, E, tid); }
        GSYNC();
        if (l == NLAYER - 1) {
            PH_BEGIN ln_phase<true>(X, p.out, nullptr, p.ln_g + (l * 3 + 2) * DM, p.ln_b + (l * 3 + 2) * DM, nullptr, nullptr, gw, NGW, lane);
        } else {
            { PH_BEGIN const float* modn = mod + (size_t)(l + 1) * NB_ * 9216;
              ln_phase<true>(X, X, Hb, p.ln_g + (l * 3 + 2) * DM, p.ln_b + (l * 3 + 2) * DM, modn + 0 * DM, modn + 1 * DM, gw, NGW, lane); }
        }
}

__global__ void __launch_bounds__(512, 2) mega_fwd(Params p_unused) {
    extern __shared__ __attribute__((aligned(16))) unsigned char lds_raw[];
    LAS unsigned char* lds = (LAS unsigned char*)lds_raw;
    CP pp = (CP)__builtin_amdgcn_kernarg_segment_ptr();
    const int wave_s = __builtin_amdgcn_readfirstlane(threadIdx.x >> 6);
    { const int l = 0; PH_BEGIN prologue(p, lds, tid, lane, wave, NBLK); }
    GSYNC();
    { const int l = 0; PH_BEGIN ln_phase<false>(p.x, nullptr, Hb, nullptr, nullptr, mod + 0 * DM, mod + 1 * DM, gw, NGW, lane); }
    GSYNC();
    layer_body<0>(pp, lds, wave_s);
    GSYNC();
    layer_body<1>(pp, lds, wave_s);
}

extern "C" void kernel_launch(void* const* d_in, const int* in_sizes, int n_in, void* d_out, int out_size, void* d_ws, size_t ws_size, hipStream_t stream) {
    static int grid_blocks = 0;
    if (grid_blocks == 0) {
        if (n_in != 34 || in_sizes[0] != MTOK * DM || out_size != MTOK * DM || ws_size < WS_END) {
            fprintf(stderr, "kernel_launch: unexpected shapes (n_in %d, in0 %d, out %d, ws %zu; need ws >= %zu); nothing launched\n", n_in, n_in > 0 ? in_sizes[0] : -1, out_size, ws_size, (size_t)WS_END);
            grid_blocks = -1; return;
        }
        int dev = 0, cus = 0, per_cu = 0;
        hipGetDevice(&dev);
        hipDeviceGetAttribute(&cus, hipDeviceAttributeMultiprocessorCount, dev);
        hipFuncSetAttribute((const void*)mega_fwd, hipFuncAttributeMaxDynamicSharedMemorySize, LDS_BYTES);
        hipOccupancyMaxActiveBlocksPerMultiprocessor(&per_cu, (const void*)mega_fwd, 512, LDS_BYTES);
        if (per_cu < 1) { fprintf(stderr, "kernel_launch: occupancy query returned %d\n", per_cu); per_cu = 1; }
        grid_blocks = cus * 1;
        (void)hipGetLastError();
    }
    if (grid_blocks < 0) return;
    hipMemsetAsync((unsigned char*)d_ws + WS_MOD, 0, MOD_BYTES, stream);
    Params p{};
    const float** fp = (const float**)&p;
    for (int i = 0; i < 34; ++i) fp[i] = (const float*)d_in[i];
    p.pos = (const int*)d_in[2];
    p.out = (float*)d_out; p.ws = (unsigned char*)d_ws;
    void* args[] = {&p};
    hipError_t e = hipLaunchCooperativeKernel((const void*)mega_fwd, dim3(grid_blocks), dim3(512), args, LDS_BYTES, stream);
    if (e != hipSuccess) fprintf(stderr, "cooperative launch failed: %s (grid %d)\n", hipGetErrorString(e), grid_blocks);
}
```
